# Optimizing an MI355X kernel written in HIP

```python
import jax, jax.numpy as jnp
from jax import lax
import numpy as np

D_MODEL = 1024
BATCH = 8
SEQ = 4096
DEPTH = 2

CHUNK = 64
GLA_HEADS = 4
KEY_WIDTH = D_MODEL // 2
VAL_WIDTH = D_MODEL
HEAD_K = KEY_WIDTH // GLA_HEADS
HEAD_V = VAL_WIDTH // GLA_HEADS
GATE_RANK = 16
GATE_TAU = 16.0
CONV_CH = D_MODEL
CONV_WIDTH = 3
FFN_HIDDEN = -(-8 * D_MODEL // (3 * 256)) * 256
IN_WIDTH = 2 * KEY_WIDTH + 2 * VAL_WIDTH + GATE_RANK + 3 * CONV_CH + 2 * D_MODEL
NORM_EPS = 1e-6

kernel_name = "gla_shortconv_gated_hybrid"


def _split_points():
    sizes = (KEY_WIDTH, KEY_WIDTH, VAL_WIDTH, VAL_WIDTH, GATE_RANK,
             CONV_CH, CONV_CH, CONV_CH, D_MODEL, D_MODEL)
    return tuple(int(v) for v in np.cumsum(sizes)[:-1])


def rmsnorm(x, g):
    xf = x.astype(jnp.float32)
    y = xf * lax.rsqrt(jnp.mean(xf * xf, axis=-1, keepdims=True) + NORM_EPS)
    return (y * g.astype(jnp.float32)).astype(x.dtype)


def gla_chunk_causal(q, k, v, log_a):
    b_sz, s_len = q.shape[0], q.shape[1]
    n_chunks = s_len // CHUNK

    def to_chunks(t):
        return t.astype(jnp.float32).reshape(b_sz, n_chunks, CHUNK, GLA_HEADS, t.shape[-1]).transpose(1, 0, 3, 2, 4)

    qc, kc, vc, lc = to_chunks(q), to_chunks(k), to_chunks(v), to_chunks(log_a)
    cum = jnp.cumsum(lc, axis=3)
    cum_end = cum[:, :, :, -1:, :]
    kd = kc * jnp.exp(cum_end - cum)
    gamma = jnp.exp(cum_end[:, :, :, 0, :])

    def step(state, inp):
        q_i, kd_i, v_i, g_i = inp
        state = g_i[..., None] * state + jnp.einsum('bhlk,bhlv->bhkv', kd_i, v_i)
        o_i = jnp.einsum('bhlk,bhkv->bhlv', q_i, state)
        return state, o_i

    s0 = jnp.zeros((b_sz, GLA_HEADS, HEAD_K, HEAD_V), jnp.float32)
    _, o = lax.scan(step, s0, (qc, kd, vc, gamma))
    return o.transpose(1, 0, 3, 2, 4).reshape(b_sz, s_len, GLA_HEADS, HEAD_V)


def causal_depthwise_conv(u, w, bias):
    rhs = w.astype(u.dtype)[:, None, :]
    y = lax.conv_general_dilated(u, rhs, window_strides=(1,), padding=[(CONV_WIDTH - 1, 0)],
                                 dimension_numbers=('NWC', 'WIO', 'NWC'),
                                 feature_group_count=u.shape[-1])
    return y + bias.astype(u.dtype)


def setup_inputs(seed: int = 0) -> dict:
    key = jax.random.key(seed)
    ks = jax.random.split(key, 20)

    def nrm(k, shape, scale):
        return jax.random.normal(k, shape, jnp.float32) * scale

    def gain(k, shape):
        return 1.0 + 0.02 * jax.random.normal(k, shape, jnp.float32)

    return {
        "x": nrm(ks[0], (BATCH, SEQ, D_MODEL), 1.0),
        "norm1_g": gain(ks[1], (DEPTH, D_MODEL)),
        "w_in": nrm(ks[2], (DEPTH, D_MODEL, IN_WIDTH), D_MODEL ** -0.5),
        "w_fg2": nrm(ks[3], (DEPTH, GATE_RANK, KEY_WIDTH), GATE_RANK ** -0.5),
        "b_fg": nrm(ks[4], (DEPTH, KEY_WIDTH), 0.01),
        "gla_norm_g": gain(ks[5], (DEPTH, HEAD_V)),
        "w_oa": nrm(ks[6], (DEPTH, VAL_WIDTH, D_MODEL), VAL_WIDTH ** -0.5),
        "conv_w": nrm(ks[7], (DEPTH, CONV_WIDTH, CONV_CH), CONV_WIDTH ** -0.5),
        "conv_b": nrm(ks[8], (DEPTH, CONV_CH), 0.01),
        "w_ob": nrm(ks[9], (DEPTH, CONV_CH, D_MODEL), CONV_CH ** -0.5),
        "w_o": nrm(ks[10], (DEPTH, D_MODEL, D_MODEL), D_MODEL ** -0.5),
        "norm2_g": gain(ks[11], (DEPTH, D_MODEL)),
        "w_ffn_gate": nrm(ks[12], (DEPTH, D_MODEL, FFN_HIDDEN), D_MODEL ** -0.5),
        "w_ffn_up": nrm(ks[13], (DEPTH, D_MODEL, FFN_HIDDEN), D_MODEL ** -0.5),
        "w_ffn_down": nrm(ks[14], (DEPTH, FFN_HIDDEN, D_MODEL), FFN_HIDDEN ** -0.5),
        "final_g": gain(ks[15], (D_MODEL,)),
    }


def reference(x, norm1_g, w_in, w_fg2, b_fg, gla_norm_g, w_oa, conv_w, conv_b, w_ob, w_o,
              norm2_g, w_ffn_gate, w_ffn_up, w_ffn_down, final_g):
    b_sz, s_len, _ = x.shape
    split_pts = _split_points()
    for l in range(DEPTH):
        h = rmsnorm(x, norm1_g[l])
        proj = jnp.einsum('bsd,de->bse', h, w_in[l])
        q, k, v, r, fz, gb_in, gc_in, cx, ga, gb = jnp.split(proj, split_pts, axis=-1)

        fg = jnp.einsum('bsr,rk->bsk', fz, w_fg2[l]) + b_fg[l]
        log_a = jax.nn.log_sigmoid(fg.astype(jnp.float32)) / GATE_TAU
        qh = q.reshape(b_sz, s_len, GLA_HEADS, HEAD_K) * (HEAD_K ** -0.5)
        kh = k.reshape(b_sz, s_len, GLA_HEADS, HEAD_K)
        vh = v.reshape(b_sz, s_len, GLA_HEADS, HEAD_V)
        ah = log_a.reshape(b_sz, s_len, GLA_HEADS, HEAD_K)
        o = gla_chunk_causal(qh, kh, vh, ah)
        o = o * lax.rsqrt(jnp.mean(o * o, axis=-1, keepdims=True) + NORM_EPS) * gla_norm_g[l].astype(jnp.float32)
        o = o.reshape(b_sz, s_len, VAL_WIDTH).astype(x.dtype) * jax.nn.silu(r)
        y_a = jnp.einsum('bsv,vd->bsd', o, w_oa[l])

        conv = causal_depthwise_conv(gc_in * cx, conv_w[l], conv_b[l])
        y_b = jnp.einsum('bsc,cd->bsd', gb_in * conv, w_ob[l])

        mix = jax.nn.sigmoid(ga) * y_a + jax.nn.sigmoid(gb) * y_b
        x = x + jnp.einsum('bsd,de->bse', mix, w_o[l])

        h2 = rmsnorm(x, norm2_g[l])
        hid = jax.nn.silu(jnp.einsum('bsd,df->bsf', h2, w_ffn_gate[l])) * jnp.einsum('bsd,df->bsf', h2, w_ffn_up[l])
        x = x + jnp.einsum('bsf,fd->bsd', hid, w_ffn_down[l])
    return rmsnorm(x, final_g)
```

```cpp
#include <hip/hip_runtime.h>
#include <hip/hip_cooperative_groups.h>
#include <cstdio>
#include <cstdint>
namespace cg = cooperative_groups;
namespace pg8 {
#define PG8_LAS __attribute__((address_space(3)))
typedef unsigned short bf16_t;
typedef short bf16x8 __attribute__((ext_vector_type(8)));
typedef float f32x4 __attribute__((ext_vector_type(4)));
typedef unsigned u32x4 __attribute__((ext_vector_type(4)));
constexpr int BM = 256, BK = 64, HALF = 128, HTB = HALF * BK * 2  , STAGE_BYTES = 8 * HTB, NXCD = 8, WGM = 8;

__host__ __device__ __forceinline__ int lds_byte(int r, int c) { const int st = (r >> 4) * 2 + (c >> 5), rr = r & 15, cc = c & 31, ob = rr * 64 + cc * 2; return st * 1024 + (ob ^ (((ob >> 9) & 1) << 5)); }
__host__ __device__ __forceinline__ void stage_rc(int b, int& R, int& C) { const int st = b / 1024, sb = b % 1024, swz = sb ^ (((sb >> 9) & 1) << 5); R = (st >> 1) * 16 + swz / 64; C = (st & 1) * 32 + (swz % 64) / 2; }
__host__ __device__ __forceinline__ int perm32(int rho) { const int n = rho >> 4, i = rho & 15; return 8 * (i >> 2) + 4 * n + (i & 3); }

struct Unit { int pm, pn, st; };
struct Gemm { const bf16_t* A; const bf16_t* Bt; int M, N, K;
    __device__ __forceinline__ const bf16_t* a_of(const Unit&) const { return A; } __device__ __forceinline__ const bf16_t* b_of(const Unit&) const { return Bt; } };
struct Gemm4 { const bf16_t *A0, *A1, *A2, *A3, *B0, *B1, *B2, *B3; int M, N, K;
    __device__ __forceinline__ const bf16_t* a_of(const Unit& u) const { return u.st == 0 ? A0 : u.st == 1 ? A1 : u.st == 2 ? A2 : A3; }
    __device__ __forceinline__ const bf16_t* b_of(const Unit& u) const { return u.st == 0 ? B0 : u.st == 1 ? B1 : u.st == 2 ? B2 : B3; } };

struct StaticOrder {
    int nM, nN, nwg, G, c;
    __host__ __device__ void init(int M, int N, int G_, int c_) { nM = M / BM; nN = N / BM; nwg = nM * nN; G = G_; c = c_; }
    __host__ __device__ bool next(int i, Unit& u) const {
        const long L = (long)i * G + c; if (L >= nwg) return false;
        int wgid = (int)L; { const int q = nwg / NXCD, r = nwg % NXCD, xcd = wgid % NXCD, off = wgid / NXCD; wgid = (xcd < r ? xcd * (q + 1) : r * (q + 1) + (xcd - r) * q) + off; }
        const int nig = WGM * nN, gid = wgid / nig, fm = gid * WGM, gsz = (nM - fm) < WGM ? (nM - fm) : WGM;
        u.pm = fm + ((wgid % nig) % gsz); u.pn = (wgid % nig) / gsz; u.st = 0; return true;
    }
    __device__ __forceinline__ void a_ready(const Unit&) const {}
    __device__ __forceinline__ void done(const Unit&) const {}
};

struct ChainOrder : StaticOrder { int tpw, ns;
    __device__ bool next(int i, Unit& u) const { if (i >= ns * tpw) return false; const bool ok = StaticOrder::next(i / ns, u); u.st = i % ns; return ok; } };
struct P1Order : StaticOrder {
    __device__ bool next(int i, Unit& u) const { const bool ok = StaticOrder::next(i, u); if (u.pn >= 8) u.pn += 4; return ok; } };

typedef float f32x2_t __attribute__((ext_vector_type(2))); typedef __bf16 bf16x2_t __attribute__((ext_vector_type(2)));
__device__ __forceinline__ unsigned cvt_pk_bf16(float lo, float hi) { f32x2_t v = {lo, hi}; bf16x2_t b = __builtin_convertvector(v, bf16x2_t); return __builtin_bit_cast(unsigned, b); }
typedef float f32x2 __attribute__((ext_vector_type(2)));
typedef unsigned u32x2 __attribute__((ext_vector_type(2)));
__device__ __forceinline__ float bf_lo(unsigned w) { return __uint_as_float(w << 16); }
__device__ __forceinline__ float bf_hi(unsigned w) { return __uint_as_float(w & 0xffff0000u); }
__device__ __forceinline__ float fsigmoid(float x) { return __builtin_amdgcn_rcpf(1.0f + __expf(-x)); }
struct RTab { const PG8_LAS float* tab; int pm0; };
#define EPI_ROWS(rs, rt, u, wr, fr) float rs[2][4]; { const PG8_LAS float* rp_ = (rt).tab + (((u).pm - (rt).pm0) >> 3) * 256 + (wr) * 64 + (fr); \
    _Pragma("unroll") for (int ai = 0; ai < 2; ++ai) _Pragma("unroll") for (int m = 0; m < 4; ++m) rs[ai][m] = rp_[ai * HALF + m * 16]; }

struct EpiInProj {
    static constexpr bool PERM = true, AFTER_DRAIN = false;
    bf16_t *Q, *Kb, *V, *R, *U, *GBIN; float* FZ; RTab rt;
    __device__ __forceinline__ void operator()(const f32x4 (&acc)[2][2][4][2], const Unit& u, int wr, int wc, int fr, int fq) const {
        const int row0 = u.pm * BM + wr * 64 + fr, pn = u.pn;
        EPI_ROWS(rs, rt, u, wr, fr)
        if (pn >= 12 && pn < 20) {
            const int col0 = (pn - 12) * 128 + wc * 32 + 8 * fq;
#pragma unroll
            for (int ai = 0; ai < 2; ++ai)
#pragma unroll
                for (int m = 0; m < 4; ++m) { const float s = rs[ai][m] * rs[ai][m];
                    const f32x4 v0 = acc[ai][0][m][0] * acc[ai][1][m][0] * s, v1 = acc[ai][0][m][1] * acc[ai][1][m][1] * s;
                    u32x4 w; w.x = cvt_pk_bf16(v0[0], v0[1]); w.y = cvt_pk_bf16(v0[2], v0[3]); w.z = cvt_pk_bf16(v1[0], v1[1]); w.w = cvt_pk_bf16(v1[2], v1[3]);
                    *(u32x4*)(U + (size_t)(row0 + ai * HALF + m * 16) * 1024 + col0) = w; }
        } else if (pn == 24) {
            if (wc == 0 && fq < 2) {
#pragma unroll
                for (int ai = 0; ai < 2; ++ai)
#pragma unroll
                    for (int m = 0; m < 4; ++m) { float* p = FZ + (size_t)(row0 + ai * HALF + m * 16) * 16 + 8 * fq;
                        *(f32x4*)p = acc[ai][0][m][0] * rs[ai][m]; *(f32x4*)(p + 4) = acc[ai][0][m][1] * rs[ai][m]; }
            }
        } else {
            bf16_t* base; int ldc, colt; float sc = 1.0f;
            if (pn < 2) { base = Q; ldc = 512; colt = pn * 256; sc = 0.08838834764831845f; }
            else if (pn < 4) { base = Kb; ldc = 512; colt = (pn - 2) * 256; }
            else if (pn < 8) { base = V; ldc = 1024; colt = (pn - 4) * 256; }
            else if (pn < 12) { base = R; ldc = 1024; colt = (pn - 8) * 256; }
            else { base = GBIN; ldc = 1024; colt = (pn - 20) * 256; }
            const int col0 = colt + wc * 32 + 8 * fq;
#pragma unroll
            for (int ai = 0; ai < 2; ++ai)
#pragma unroll
                for (int m = 0; m < 4; ++m) { const float s = rs[ai][m] * sc; bf16_t* rowp = base + (size_t)(row0 + ai * HALF + m * 16) * ldc + col0;
#pragma unroll
                    for (int bj = 0; bj < 2; ++bj) { const f32x4 v0 = acc[ai][bj][m][0] * s, v1 = acc[ai][bj][m][1] * s;
                        u32x4 w; w.x = cvt_pk_bf16(v0[0], v0[1]); w.y = cvt_pk_bf16(v0[2], v0[3]); w.z = cvt_pk_bf16(v1[0], v1[1]); w.w = cvt_pk_bf16(v1[2], v1[3]);
                        *(u32x4*)(rowp + bj * HALF) = w; } }
        }
    }
};
struct EpiGate {
    static constexpr bool PERM = true, AFTER_DRAIN = false;
    bf16_t* G; RTab rt;
    __device__ __forceinline__ void operator()(const f32x4 (&acc)[2][2][4][2], const Unit& u, int wr, int wc, int fr, int fq) const {
        const int row0 = u.pm * BM + wr * 64 + fr, col0 = u.pn * BM + wc * 32 + 8 * fq;
        EPI_ROWS(rs, rt, u, wr, fr)
#pragma unroll
        for (int ai = 0; ai < 2; ++ai)
#pragma unroll
            for (int m = 0; m < 4; ++m) { const float s = rs[ai][m]; bf16_t* rowp = G + (size_t)(row0 + ai * HALF + m * 16) * 1024 + col0;
#pragma unroll
                for (int bj = 0; bj < 2; ++bj) { const f32x4 v0 = acc[ai][bj][m][0] * s, v1 = acc[ai][bj][m][1] * s;
                    u32x4 w; w.x = cvt_pk_bf16(fsigmoid(v0[0]), fsigmoid(v0[1])); w.y = cvt_pk_bf16(fsigmoid(v0[2]), fsigmoid(v0[3]));
                    w.z = cvt_pk_bf16(fsigmoid(v1[0]), fsigmoid(v1[1])); w.w = cvt_pk_bf16(fsigmoid(v1[2]), fsigmoid(v1[3]));
                    *(u32x4*)(rowp + bj * HALF) = w; } }
    }
};
template <int ADD> struct EpiMix {
    static constexpr bool PERM = true, AFTER_DRAIN = false;
    const bf16_t* G; bf16_t* MIX;
    __device__ __forceinline__ void operator()(const f32x4 (&acc)[2][2][4][2], const Unit& u, int wr, int wc, int fr, int fq) const {
        const int row0 = u.pm * BM + wr * 64 + fr, col0 = u.pn * BM + wc * 32 + 8 * fq;
#pragma unroll
        for (int ai = 0; ai < 2; ++ai) {
            u32x4 g[4][2], o[4][2];
#pragma unroll
            for (int m = 0; m < 4; ++m)
#pragma unroll
                for (int bj = 0; bj < 2; ++bj) { const size_t off = (size_t)(row0 + ai * HALF + m * 16) * 1024 + col0 + bj * HALF;
                    g[m][bj] = *(const u32x4*)(G + off); o[m][bj] = (u32x4){0u, 0u, 0u, 0u}; if (ADD) o[m][bj] = *(const u32x4*)(MIX + off); }
#pragma unroll
            for (int m = 0; m < 4; ++m)
#pragma unroll
                for (int bj = 0; bj < 2; ++bj) { const size_t off = (size_t)(row0 + ai * HALF + m * 16) * 1024 + col0 + bj * HALF;
                    const f32x4 a0 = acc[ai][bj][m][0], a1 = acc[ai][bj][m][1]; const u32x4 gg = g[m][bj], oo = o[m][bj];
                    u32x4 w;
                    w.x = cvt_pk_bf16(bf_lo(oo.x) + bf_lo(gg.x) * a0[0], bf_hi(oo.x) + bf_hi(gg.x) * a0[1]);
                    w.y = cvt_pk_bf16(bf_lo(oo.y) + bf_lo(gg.y) * a0[2], bf_hi(oo.y) + bf_hi(gg.y) * a0[3]);
                    w.z = cvt_pk_bf16(bf_lo(oo.z) + bf_lo(gg.z) * a1[0], bf_hi(oo.z) + bf_hi(gg.z) * a1[1]);
                    w.w = cvt_pk_bf16(bf_lo(oo.w) + bf_lo(gg.w) * a1[2], bf_hi(oo.w) + bf_hi(gg.w) * a1[3]);
                    *(u32x4*)(MIX + off) = w; }
            asm volatile("" ::: "memory"); }
    }
};
struct EpiRes {
    static constexpr bool PERM = true, AFTER_DRAIN = false;
    bf16_t* XB; float* ssq;
    __device__ __forceinline__ void operator()(const f32x4 (&acc)[2][2][4][2], const Unit& u, int wr, int wc, int fr, int fq) const {
        const int row0 = u.pm * BM + wr * 64 + fr, col0 = u.pn * BM + wc * 32 + 8 * fq;
#pragma unroll
        for (int ai = 0; ai < 2; ++ai) {
            u32x4 xi[4][2];
#pragma unroll
            for (int m = 0; m < 4; ++m)
#pragma unroll
                for (int bj = 0; bj < 2; ++bj) xi[m][bj] = *(const u32x4*)(XB + (size_t)(row0 + ai * HALF + m * 16) * 1024 + col0 + bj * HALF);
#pragma unroll
            for (int m = 0; m < 4; ++m) { const int row = row0 + ai * HALF + m * 16; float q = 0.f;
#pragma unroll
                for (int bj = 0; bj < 2; ++bj) { const size_t off = (size_t)row * 1024 + col0 + bj * HALF; const u32x4 x = xi[m][bj]; const f32x4 a0 = acc[ai][bj][m][0], a1 = acc[ai][bj][m][1];
                    u32x4 w; w.x = cvt_pk_bf16(bf_lo(x.x) + a0[0], bf_hi(x.x) + a0[1]); w.y = cvt_pk_bf16(bf_lo(x.y) + a0[2], bf_hi(x.y) + a0[3]);
                    w.z = cvt_pk_bf16(bf_lo(x.z) + a1[0], bf_hi(x.z) + a1[1]); w.w = cvt_pk_bf16(bf_lo(x.w) + a1[2], bf_hi(x.w) + a1[3]);
                    *(u32x4*)(XB + off) = w;
                    const float r0 = bf_lo(w.x), r1 = bf_hi(w.x), r2 = bf_lo(w.y), r3 = bf_hi(w.y), r4 = bf_lo(w.z), r5 = bf_hi(w.z), r6 = bf_lo(w.w), r7 = bf_hi(w.w);
                    q += ((r0 * r0 + r1 * r1) + (r2 * r2 + r3 * r3)) + ((r4 * r4 + r5 * r5) + (r6 * r6 + r7 * r7)); }
                q += __shfl_xor(q, 16); q += __shfl_xor(q, 32);
                if (fq == 0) ssq[(size_t)row * 16 + u.pn * 4 + wc] = q; }
            asm volatile("" ::: "memory"); }
    }
};
struct EpiFfn1 {
    static constexpr bool PERM = true, AFTER_DRAIN = false;
    bf16_t* HID; RTab rt;
    __device__ __forceinline__ void operator()(const f32x4 (&acc)[2][2][4][2], const Unit& u, int wr, int wc, int fr, int fq) const {
        const int row0 = u.pm * BM + wr * 64 + fr, col0 = u.pn * 128 + wc * 32 + 8 * fq;
        EPI_ROWS(rs, rt, u, wr, fr)
#pragma unroll
        for (int ai = 0; ai < 2; ++ai)
#pragma unroll
            for (int m = 0; m < 4; ++m) { const float s = rs[ai][m]; float h[8];
#pragma unroll
                for (int n = 0; n < 2; ++n)
#pragma unroll
                    for (int j = 0; j < 4; ++j) { const float g = acc[ai][0][m][n][j] * s, up = acc[ai][1][m][n][j] * s; h[4 * n + j] = g * fsigmoid(g) * up; }
                u32x4 w; w.x = cvt_pk_bf16(h[0], h[1]); w.y = cvt_pk_bf16(h[2], h[3]); w.z = cvt_pk_bf16(h[4], h[5]); w.w = cvt_pk_bf16(h[6], h[7]);
                *(u32x4*)(HID + (size_t)(row0 + ai * HALF + m * 16) * 2816 + col0) = w; }
    }
};

struct EpiO {
    static constexpr bool PERM = true, AFTER_DRAIN = false;
    bf16_t* V; const float* gssq; const float* gn; RTab rt;
    __device__ __forceinline__ void operator()(const f32x4 (&acc)[2][2][4][2], const Unit& u, int wr, int wc, int fr, int fq) const {
        const int row0 = u.pm * BM + wr * 64 + fr, cw = wc * 32 + 8 * fq, col0 = u.pn * BM + cw;
        float hr[2][4];
        { f32x4 hs[2][4];
#pragma unroll
          for (int ai = 0; ai < 2; ++ai)
#pragma unroll
              for (int m = 0; m < 4; ++m) { const float* gq = gssq + (size_t)(u.pn * 16 + 4 * fq) * 32768 + (row0 + ai * HALF + m * 16);
                  hs[ai][m] = (f32x4){gq[0], gq[32768], gq[2 * 32768], gq[3 * 32768]}; }
#pragma unroll
          for (int ai = 0; ai < 2; ++ai)
#pragma unroll
              for (int m = 0; m < 4; ++m) { float t = (hs[ai][m].x + hs[ai][m].y) + (hs[ai][m].z + hs[ai][m].w); t += __shfl_xor(t, 16); t += __shfl_xor(t, 32);
                  hr[ai][m] = __builtin_amdgcn_rsqf(t * (1.0f / 256.0f) + 1e-6f); } }
        asm volatile("" ::: "memory");
        EPI_ROWS(rs, rt, u, wr, fr)
        f32x4 gv[2][2];
#pragma unroll
        for (int bj = 0; bj < 2; ++bj)
#pragma unroll
            for (int n = 0; n < 2; ++n) gv[bj][n] = *(const f32x4*)(gn + cw + bj * HALF + 4 * n);
#pragma unroll
        for (int ai = 0; ai < 2; ++ai)
#pragma unroll
            for (int mp = 0; mp < 2; ++mp) {
                u32x4 xo[2][2];
#pragma unroll
                for (int mm = 0; mm < 2; ++mm)
#pragma unroll
                    for (int bj = 0; bj < 2; ++bj) xo[mm][bj] = *(const u32x4*)(V + (size_t)(row0 + ai * HALF + (2 * mp + mm) * 16) * 1024 + col0 + bj * HALF);
#pragma unroll
                for (int mm = 0; mm < 2; ++mm) { const int m = 2 * mp + mm; const size_t row = (size_t)(row0 + ai * HALF + m * 16); const float h = hr[ai][m], s = rs[ai][m];
#pragma unroll
                    for (int bj = 0; bj < 2; ++bj) { const u32x4 x = xo[mm][bj]; const f32x4 r0 = acc[ai][bj][m][0] * s, r1 = acc[ai][bj][m][1] * s, g0 = gv[bj][0] * h, g1 = gv[bj][1] * h;
                        u32x4 w;
                        w.x = cvt_pk_bf16(bf_lo(x.x) * g0[0] * (r0[0] * fsigmoid(r0[0])), bf_hi(x.x) * g0[1] * (r0[1] * fsigmoid(r0[1])));
                        w.y = cvt_pk_bf16(bf_lo(x.y) * g0[2] * (r0[2] * fsigmoid(r0[2])), bf_hi(x.y) * g0[3] * (r0[3] * fsigmoid(r0[3])));
                        w.z = cvt_pk_bf16(bf_lo(x.z) * g1[0] * (r1[0] * fsigmoid(r1[0])), bf_hi(x.z) * g1[1] * (r1[1] * fsigmoid(r1[1])));
                        w.w = cvt_pk_bf16(bf_lo(x.w) * g1[2] * (r1[2] * fsigmoid(r1[2])), bf_hi(x.w) * g1[3] * (r1[3] * fsigmoid(r1[3])));
                        *(u32x4*)(V + row * 1024 + col0 + bj * HALF) = w; } }
                asm volatile("" ::: "memory"); }
    }
};
struct EpiX {
    static constexpr bool PERM = true, AFTER_DRAIN = false;
    EpiO o; EpiGate g0; EpiGate g1;
    __device__ __forceinline__ void operator()(const f32x4 (&acc)[2][2][4][2], const Unit& u, int wr, int wc, int fr, int fq) const {
        if (u.st == 0) o(acc, u, wr, wc, fr, fq); else if (u.st == 1) g0(acc, u, wr, wc, fr, fq); else g1(acc, u, wr, wc, fr, fq);
    }
};
struct EpiY {
    static constexpr bool PERM = true, AFTER_DRAIN = false;
    EpiMix<0> m0; EpiMix<1> m1;
    __device__ __forceinline__ void operator()(const f32x4 (&acc)[2][2][4][2], const Unit& u, int wr, int wc, int fr, int fq) const {
        if (u.st == 0) m0(acc, u, wr, wc, fr, fq); else m1(acc, u, wr, wc, fr, fq);
    }
};

template <class Epi, class Sched, bool ALIGN_EPI = false, bool SP2 = false, class GemmT = Gemm>
__device__ __forceinline__ void gemm_phase(PG8_LAS unsigned char* lds, const GemmT g, const Sched& S, const Epi& E) {
    int tid_ = threadIdx.x; asm volatile("" : "+v"(tid_));
    const int tid = tid_, wid = __builtin_amdgcn_readfirstlane(tid >> 6), lane = tid & 63, wr = wid >> 2, wc = wid & 3, fr = lane & 15, fq = lane >> 4;
    const int K = g.K, nt = K / BK;
    unsigned voffA[2], voffB[2];
#pragma unroll
    for (int i = 0; i < 2; ++i) { int R, C; stage_rc(tid * 16 + i * 8192, R, C); const int Rb = Epi::PERM ? ((R & ~31) + perm32(R & 31)) : R;
        voffA[i] = (unsigned)(R * K + C) * 2u; voffB[i] = (unsigned)(Rb * K + C) * 2u; }
    const size_t kstep = (size_t)(BK * 2);
    const size_t hstep = (size_t)HALF * K * 2;
    const size_t tstep = 2 * hstep;
    const unsigned ldsw = (unsigned)wid * 1024u;
    const int aoff = lds_byte(wr * 64 + fr, fq * 8), boff = lds_byte(wc * 32 + fr, fq * 8);
#define PG8_SA(b, h) (((b) * 2 + (h)) * HTB)
#define PG8_SB(b, h) ((4 + (b) * 2 + (h)) * HTB)
#define PG8_STAGE(bufoff, gbase, voff) do { _Pragma("unroll") for (int _i = 0; _i < 2; ++_i) \
        __builtin_amdgcn_global_load_lds((const unsigned*)((const char*)(gbase) + (voff)[_i]), (PG8_LAS unsigned*)(lds + (bufoff) + ldsw + _i * 8192), 16, 0, 0); } while (0)
#define PG8_LDA(dst, b, h) do { _Pragma("unroll") for (int m = 0; m < 4; ++m) _Pragma("unroll") for (int k = 0; k < 2; ++k) dst[m][k] = *(const PG8_LAS bf16x8*)(lds + PG8_SA(b, h) + aoff + m * 2048 + k * 1024); } while (0)
#define PG8_LDB(dst, b, h) do { _Pragma("unroll") for (int n = 0; n < 2; ++n) _Pragma("unroll") for (int k = 0; k < 2; ++k) dst[n][k] = *(const PG8_LAS bf16x8*)(lds + PG8_SB(b, h) + boff + n * 2048 + k * 1024); } while (0)
#define PG8_MMA(ai, bj, At, Bt) do { __builtin_amdgcn_s_setprio(1); _Pragma("unroll") for (int m = 0; m < 4; ++m) _Pragma("unroll") for (int n = 0; n < 2; ++n) _Pragma("unroll") for (int k = 0; k < 2; ++k) \
        acc[ai][bj][m][n] = __builtin_amdgcn_mfma_f32_16x16x32_bf16(Bt[n][k], At[m][k], acc[ai][bj][m][n], 0, 0, 0); __builtin_amdgcn_s_setprio(0); } while (0)
#define PG8_WAIT_V(n) asm volatile("s_waitcnt vmcnt(" #n ")" ::: "memory")
#define PG8_WAIT_L(n) asm volatile("s_waitcnt lgkmcnt(" #n ")" ::: "memory")
#define PG8_BAR __builtin_amdgcn_s_barrier()
#define PG8_SCHED __builtin_amdgcn_sched_barrier(0)
    Unit cur, nxt; int ui = 0;
    if (!S.next(0, cur)) return;
    f32x4 acc[2][2][4][2];
#pragma unroll
    for (int a = 0; a < 2; ++a)
#pragma unroll
        for (int b = 0; b < 2; ++b)
#pragma unroll
            for (int m = 0; m < 4; ++m)
#pragma unroll
                for (int n = 0; n < 2; ++n) acc[a][b][m][n] = (f32x4){0.f, 0.f, 0.f, 0.f};
    bf16x8 At[4][2], B0[2][2], B1[2][2];
    const char* cA = (const char*)g.a_of(cur) + (size_t)cur.pm * tstep; const char* cB = (const char*)g.b_of(cur) + (size_t)cur.pn * tstep;
    S.a_ready(cur);
    if constexpr (SP2) {
        PG8_STAGE(PG8_SB(0, 0), cB, voffB); PG8_STAGE(PG8_SB(0, 1), cB + hstep, voffB); PG8_STAGE(PG8_SA(0, 0), cA, voffA); PG8_STAGE(PG8_SA(0, 1), cA + hstep, voffA);
        if (wr == 1) PG8_BAR;
        PG8_WAIT_V(2); PG8_BAR;
        PG8_STAGE(PG8_SB(1, 0), cB + kstep, voffB); PG8_STAGE(PG8_SA(1, 0), cA + kstep, voffA); PG8_STAGE(PG8_SB(1, 1), cB + hstep + kstep, voffB);
        PG8_WAIT_V(6); PG8_BAR;
    } else {
        PG8_STAGE(PG8_SB(0, 0), cB, voffB); PG8_STAGE(PG8_SA(0, 0), cA, voffA); PG8_STAGE(PG8_SB(0, 1), cB + hstep, voffB); PG8_STAGE(PG8_SA(0, 1), cA + hstep, voffA);
        if (wr == 1) PG8_BAR;
        PG8_WAIT_V(4); PG8_BAR;
        PG8_STAGE(PG8_SB(1, 0), cB + kstep, voffB); PG8_STAGE(PG8_SA(1, 0), cA + kstep, voffA); PG8_STAGE(PG8_SB(1, 1), cB + hstep + kstep, voffB);
        PG8_WAIT_V(6); PG8_BAR;
    }
    for (;;) {
        const bool has_next = S.next(ui + 1, nxt);
        const char* nA = has_next ? (const char*)g.a_of(nxt) + (size_t)nxt.pm * tstep : cA; const char* nB = has_next ? (const char*)g.b_of(nxt) + (size_t)nxt.pn * tstep : cB;
        for (int t = 0; t < nt; t += 2) {
            const bool last = (t == nt - 2);
            const char* a1 = cA + (size_t)(t + 1) * kstep;
            const char* a2 = last ? nA : cA + (size_t)(t + 2) * kstep; const char* b2 = last ? nB : cB + (size_t)(t + 2) * kstep;
            const char* a3 = a2 + kstep; const char* b3 = b2 + kstep;
            if (last && has_next) S.a_ready(nxt);
            if constexpr (SP2) {
            PG8_LDB(B0, 0, 0); PG8_LDB(B1, 0, 1); PG8_SCHED; PG8_LDA(At, 0, 0); PG8_STAGE(PG8_SA(1, 1), a1 + hstep, voffA);
            PG8_WAIT_V(8); PG8_WAIT_L(0); PG8_BAR; PG8_MMA(0, 0, At, B0); PG8_MMA(0, 1, At, B1); PG8_BAR; PG8_SCHED;
            PG8_LDA(At, 0, 1); PG8_STAGE(PG8_SB(0, 0), b2, voffB); PG8_STAGE(PG8_SB(0, 1), b2 + hstep, voffB); PG8_STAGE(PG8_SA(0, 0), a2, voffA);
            PG8_WAIT_V(8); PG8_WAIT_L(0); PG8_BAR; PG8_MMA(1, 0, At, B0); PG8_MMA(1, 1, At, B1); PG8_BAR; PG8_SCHED;
            PG8_LDB(B0, 1, 0); PG8_LDB(B1, 1, 1); PG8_SCHED; PG8_LDA(At, 1, 0); PG8_STAGE(PG8_SA(0, 1), a2 + hstep, voffA);
            PG8_WAIT_V(8); PG8_WAIT_L(0); PG8_BAR; PG8_MMA(0, 0, At, B0); PG8_MMA(0, 1, At, B1); PG8_BAR; PG8_SCHED;
            PG8_LDA(At, 1, 1); PG8_STAGE(PG8_SB(1, 0), b3, voffB); PG8_STAGE(PG8_SB(1, 1), b3 + hstep, voffB); PG8_STAGE(PG8_SA(1, 0), a3, voffA);
            PG8_WAIT_V(8); PG8_WAIT_L(0); PG8_BAR; PG8_MMA(1, 0, At, B0); PG8_MMA(1, 1, At, B1); PG8_BAR; PG8_SCHED;
            } else {
            PG8_LDB(B0, 0, 0); PG8_SCHED; PG8_LDA(At, 0, 0); PG8_STAGE(PG8_SA(1, 1), a1 + hstep, voffA);
            PG8_WAIT_L(8); PG8_BAR; PG8_WAIT_L(0); PG8_MMA(0, 0, At, B0); PG8_BAR; PG8_SCHED;
            PG8_LDB(B1, 0, 1); PG8_STAGE(PG8_SB(0, 0), b2, voffB);
            PG8_BAR; PG8_WAIT_L(0); PG8_MMA(0, 1, At, B1); PG8_BAR;
            PG8_LDA(At, 0, 1); PG8_STAGE(PG8_SA(0, 0), a2, voffA);
            PG8_BAR; PG8_WAIT_L(0); PG8_MMA(1, 0, At, B0); PG8_BAR; PG8_SCHED;
            PG8_STAGE(PG8_SB(0, 1), b2 + hstep, voffB);
            PG8_WAIT_V(6); PG8_BAR; PG8_MMA(1, 1, At, B1); PG8_BAR;
            PG8_LDB(B0, 1, 0); PG8_SCHED; PG8_LDA(At, 1, 0); PG8_STAGE(PG8_SA(0, 1), a2 + hstep, voffA);
            PG8_WAIT_L(8); PG8_BAR; PG8_WAIT_L(0); PG8_MMA(0, 0, At, B0); PG8_BAR; PG8_SCHED;
            PG8_LDB(B1, 1, 1); PG8_STAGE(PG8_SB(1, 0), b3, voffB);
            PG8_BAR; PG8_WAIT_L(0); PG8_MMA(0, 1, At, B1); PG8_BAR;
            PG8_LDA(At, 1, 1); PG8_STAGE(PG8_SA(1, 0), a3, voffA);
            PG8_BAR; PG8_WAIT_L(0); PG8_MMA(1, 0, At, B0); PG8_BAR; PG8_SCHED;
            PG8_STAGE(PG8_SB(1, 1), b3 + hstep, voffB);
            PG8_WAIT_V(6); PG8_BAR; PG8_MMA(1, 1, At, B1); PG8_BAR;
            }
        }
        if constexpr (ALIGN_EPI) { if (wr == 0) PG8_BAR; }
        if constexpr (!Epi::AFTER_DRAIN) { E(acc, cur, wr, wc, fr, fq); S.done(cur); }
        if (!has_next) break;
#pragma unroll
        for (int a = 0; a < 2; ++a)
#pragma unroll
            for (int b = 0; b < 2; ++b)
#pragma unroll
                for (int m = 0; m < 4; ++m)
#pragma unroll
                    for (int n = 0; n < 2; ++n) acc[a][b][m][n] = (f32x4){0.f, 0.f, 0.f, 0.f};
        cur = nxt; cA = nA; cB = nB; ++ui;
        if constexpr (ALIGN_EPI) { if (wr == 1) PG8_BAR; }
    }
    PG8_WAIT_V(0);
    if constexpr (!ALIGN_EPI) { if (wr == 0) PG8_BAR; }
    PG8_BAR;
    if constexpr (Epi::AFTER_DRAIN) { E.fused(acc, cur, wr, wc, fr, fq, lds, wid, lane); S.done(cur); }
#undef PG8_SA
#undef PG8_SB
#undef PG8_STAGE
#undef PG8_LDA
#undef PG8_LDB
#undef PG8_MMA
#undef PG8_WAIT_V
#undef PG8_WAIT_L
#undef PG8_BAR
#undef PG8_SCHED
}
}

#define LAS __attribute__((address_space(3)))
typedef unsigned short bf16;
typedef float f32x4 __attribute__((ext_vector_type(4)));
typedef short bf16x8 __attribute__((ext_vector_type(8)));
typedef unsigned v4u __attribute__((ext_vector_type(4)));
typedef unsigned v2u __attribute__((ext_vector_type(2)));

constexpr int M = 32768, D = 1024, SEQ = 4096, NIN = 8208, NIN1 = 6400, FF = 2816, NGU = 5632;
constexpr size_t MiB = 1u << 20;
constexpr size_t WS_W0 = 1 * MiB, WS_WL = 40 * MiB;
constexpr size_t WO_IN = 0, WO_OA = 17 * MiB, WO_OB = 19 * MiB, WO_O = 21 * MiB, WO_GU = 23 * MiB, WO_D = 34 * MiB;
constexpr size_t WS_SSQ = 81 * MiB, WS_GSSQ = 83 * MiB, WS_FZ = 91 * MiB, WS_XB = 96 * MiB, WS_Q = 160 * MiB, WS_K = 192 * MiB, WS_V = 224 * MiB,
                 WS_R = 288 * MiB, WS_U = 352 * MiB, WS_GBIN = 416 * MiB, WS_KDT = 480 * MiB, WS_END = 512 * MiB;
constexpr size_t WS_GAM = 93 * MiB;
constexpr size_t WS_GA = WS_Q, WS_GB = WS_R, WS_HID = WS_Q;
constexpr int LDS_BYTES = 147456;

#define LDS_WAIT() asm volatile("s_waitcnt lgkmcnt(0)" ::: "memory")
__device__ __forceinline__ unsigned f2bf(float f) { unsigned u = __builtin_bit_cast(unsigned, f); return (u + 0x7fffu + ((u >> 16) & 1u)) >> 16; }
__device__ __forceinline__ unsigned pk2(float lo, float hi) { return pg8::cvt_pk_bf16(lo, hi); }
__device__ __forceinline__ float wave_sum(float v) {
#pragma unroll
    for (int o = 1; o < 64; o <<= 1) v += __shfl_xor(v, o);
    return v;
}
__device__ __forceinline__ float bflo(unsigned w) { return __uint_as_float(w << 16); }
__device__ __forceinline__ float bfhi(unsigned w) { return __uint_as_float(w & 0xffff0000u); }
__device__ __forceinline__ void load16(const bf16* p, float (&f)[16]) {
    const v4u a = *(const v4u*)p, b = *(const v4u*)(p + 8);
    f[0] = bflo(a.x); f[1] = bfhi(a.x); f[2] = bflo(a.y); f[3] = bfhi(a.y); f[4] = bflo(a.z); f[5] = bfhi(a.z); f[6] = bflo(a.w); f[7] = bfhi(a.w);
    f[8] = bflo(b.x); f[9] = bfhi(b.x); f[10] = bflo(b.y); f[11] = bfhi(b.y); f[12] = bflo(b.z); f[13] = bfhi(b.z); f[14] = bflo(b.w); f[15] = bfhi(b.w);
}
__device__ __forceinline__ void store16(bf16* p, const float (&f)[16]) {
    v4u a, b; a.x = pk2(f[0], f[1]); a.y = pk2(f[2], f[3]); a.z = pk2(f[4], f[5]); a.w = pk2(f[6], f[7]);
    b.x = pk2(f[8], f[9]); b.y = pk2(f[10], f[11]); b.z = pk2(f[12], f[13]); b.w = pk2(f[14], f[15]);
    *(v4u*)p = a; *(v4u*)(p + 8) = b;
}

__device__ __forceinline__ void load8(const bf16* p, float (&f)[8]) {
    const v4u a = *(const v4u*)p;
    f[0] = bflo(a.x); f[1] = bfhi(a.x); f[2] = bflo(a.y); f[3] = bfhi(a.y); f[4] = bflo(a.z); f[5] = bfhi(a.z); f[6] = bflo(a.w); f[7] = bfhi(a.w);
}
__device__ __forceinline__ void store8(bf16* p, const float (&f)[8]) {
    v4u a; a.x = pk2(f[0], f[1]); a.y = pk2(f[2], f[3]); a.z = pk2(f[4], f[5]); a.w = pk2(f[6], f[7]); *(v4u*)p = a;
}

template <bool GAIN> __device__ __forceinline__ void tr_item_(const float* W, int Nsrc, int col, const float* gain, bf16* WT, int K, int drow0, int k0, LAS float* scr, int lane) {
    const int colc = col >= 0 ? col : 0; const float msk = col >= 0 ? 1.f : 0.f;
    float vv[32];
#pragma unroll
    for (int i = 0; i < 32; ++i) { const int kk = 2 * i + (lane >> 5); vv[i] = W[(size_t)(k0 + kk) * Nsrc + colc]; }
    if (GAIN) {
        float gg[32];
#pragma unroll
        for (int i = 0; i < 32; ++i) gg[i] = gain[k0 + 2 * i + (lane >> 5)];
#pragma unroll
        for (int i = 0; i < 32; ++i) vv[i] *= gg[i];
    }
#pragma unroll
    for (int i = 0; i < 32; ++i) { const int kk = 2 * i + (lane >> 5); scr[kk * 33 + (lane & 31)] = vv[i] * msk; }
    LDS_WAIT(); asm volatile("" ::: "memory");
    const int c = lane & 7;
#pragma unroll
    for (int j = 0; j < 4; ++j) { const int n = (lane >> 3) + 8 * j; const LAS float* s = scr + (8 * c) * 33 + n;
        v4u o; o.x = pk2(s[0 * 33], s[1 * 33]); o.y = pk2(s[2 * 33], s[3 * 33]); o.z = pk2(s[4 * 33], s[5 * 33]); o.w = pk2(s[6 * 33], s[7 * 33]);
        *(v4u*)(WT + (size_t)(drow0 + n) * K + k0 + 8 * c) = o; }
    LDS_WAIT(); asm volatile("" ::: "memory");
}
__device__ __forceinline__ void tr_item(const float* W, int Nsrc, int col, const float* gain, bf16* WT, int K, int drow0, int k0, LAS float* scr, int lane) {
    if (gain) tr_item_<true>(W, Nsrc, col, gain, WT, K, drow0, k0, scr, lane); else tr_item_<false>(W, Nsrc, col, gain, WT, K, drow0, k0, scr, lane);
}
__device__ __forceinline__ int in_src_col(int d) {
    if (d < 3072) return d;
    if (d < 5120) { const int j = (d - 3072) >> 8, i = (d - 3072) & 255; return i < 128 ? 4112 + 128 * j + i : 5136 + 128 * j + (i - 128); }
    if (d < 6144) return 3088 + (d - 5120);
    if (d < 6400) { const int i = d - 6144; return i < 16 ? 3072 + i : -1; }
    return 6160 + (d - 6400);
}

struct Args { const float* in[16]; float* out; unsigned char* ws; };

#define RLX_AGENT __ATOMIC_RELAXED, __HIP_MEMORY_SCOPE_AGENT
#define XB_TMO      128
#define XB_XCNT(j)  (256  + 64 * (j))
#define XB_XSUB(j)  (1280 + 64 * (j))
#define XB_XGEN(j)  (2304 + 64 * (j))
#define XB_TOP      3328
#define XB_TOPGEN   3392
#define XCD_BAR_WORDS 3456
#define XB_SPIN_CAP (1u << 18)

__device__ __forceinline__ unsigned xb_ld(unsigned* p)              { return __hip_atomic_load(p, __ATOMIC_RELAXED, __HIP_MEMORY_SCOPE_AGENT); }
__device__ __forceinline__ unsigned xb_add(unsigned* p, unsigned v) { return __hip_atomic_fetch_add(p, v, __ATOMIC_RELAXED, __HIP_MEMORY_SCOPE_AGENT); }
__device__ __forceinline__ unsigned xb_xcc_id() { return (unsigned)__builtin_amdgcn_s_getreg((3 << 11) | 20) & 0xFu; }
#define XB_SPIN(cond, bar) do { unsigned _sp = 0; while (cond) { __builtin_amdgcn_s_sleep(1); \
    if ((++_sp & 255u) == 0u) { if (xb_ld(&(bar)[XB_TMO])) break; if (_sp > XB_SPIN_CAP) { atomicAdd(&(bar)[XB_TMO], 1u); break; } } } } while (0)

struct XcdBarrier {
    unsigned* bar; unsigned x;
    volatile LAS unsigned* st;
};

__device__ __forceinline__ XcdBarrier xcd_barrier_post(unsigned* bar, volatile LAS unsigned* st) {
    XcdBarrier b; b.bar = bar; b.x = xb_xcc_id(); b.st = st;
    if (threadIdx.x == 0) (void)xb_add(&bar[XB_XCNT(b.x)], 1u);
    return b;
}
__device__ __forceinline__ void xcd_barrier_complete(unsigned* bar, unsigned x, unsigned& nloc, unsigned& nx) {
    const unsigned G = gridDim.x * gridDim.y * gridDim.z;
    unsigned sum, cnt, mine, sp = 0u;
    for (;;) {
        sum = 0u; cnt = 0u; mine = 0u;
#pragma unroll
        for (unsigned j = 0; j < 16; ++j) { const unsigned c = xb_ld(&bar[XB_XCNT(j)]); sum += c; cnt += (c > 0u) ? 1u : 0u; mine = (j == x) ? c : mine; }
        if (sum == G) break;
        __builtin_amdgcn_s_sleep(1);
        if ((++sp & 255u) == 0u) { if (xb_ld(&bar[XB_TMO])) break; if (sp > XB_SPIN_CAP) { atomicAdd(&bar[XB_TMO], 1u); break; } }
    }
    nloc = mine > 0u ? mine : 1u; nx = cnt > 0u ? cnt : 1u;
}

__device__ __forceinline__ void xcd_barrier(const XcdBarrier& b) {
    asm volatile("s_waitcnt vmcnt(0)" ::: "memory");
    __syncthreads();
    if (threadIdx.x == 0) {
        unsigned* bar = b.bar;
        __builtin_amdgcn_s_waitcnt(0);
        unsigned nloc = b.st[0], nx = b.st[1];
        if (nloc == 0u) { xcd_barrier_complete(bar, b.x, nloc, nx); b.st[0] = nloc; b.st[1] = nx; }
        const unsigned old = xb_add(&bar[XB_XSUB(b.x)], 1u);
        const unsigned gen = old / nloc;
        if (old + 1u == (gen + 1u) * nloc) {
            __builtin_amdgcn_fence(__ATOMIC_RELEASE, "agent");
            asm volatile("s_waitcnt vmcnt(0)" ::: "memory");
            const unsigned og = xb_add(&bar[XB_TOP], 1u);
            const unsigned tg = og / nx;
            if (og + 1u == (tg + 1u) * nx) xb_add(&bar[XB_TOPGEN], 1u);
            else XB_SPIN(xb_ld(&bar[XB_TOPGEN]) == tg, bar);
            __builtin_amdgcn_fence(__ATOMIC_ACQUIRE, "agent");
            xb_add(&bar[XB_XGEN(b.x)], 1u);
            asm volatile("s_waitcnt vmcnt(0)" ::: "memory");
        } else {
            XB_SPIN(xb_ld(&bar[XB_XGEN(b.x)]) == gen, bar);
            __builtin_amdgcn_fence(__ATOMIC_ACQUIRE, "agent");
            asm volatile("s_waitcnt vmcnt(0)" ::: "memory");
        }
    }
    __syncthreads();
}

template <int OFF> __device__ __forceinline__ const void* karg_ptr() {
    unsigned long long v; auto k = __builtin_amdgcn_kernarg_segment_ptr();
    asm volatile("s_load_dwordx2 %0, %1, %2\n\ts_waitcnt lgkmcnt(0)" : "=s"(v) : "s"(k), "n"(OFF) : "memory");
    return (const void*)(const __attribute__((address_space(1))) void*)v; }
#define IN_PTR(i) ((const float*)karg_ptr<8 * (i)>())
#define OUT_PTR() ((float*)karg_ptr<128>())
#define WS_PTR() ((unsigned char*)karg_ptr<136>())

__device__ __forceinline__ int otid() { int t = threadIdx.x; asm volatile("" : "+v"(t)); return t; }
__device__ __forceinline__ int obx() { int t = blockIdx.x; asm volatile("" : "+s"(t)); return t; }
__device__ __forceinline__ int ogdim() { int t = gridDim.x; asm volatile("" : "+s"(t)); return t; }

#define LDS_BAR() do { asm volatile("s_waitcnt lgkmcnt(0)" ::: "memory"); __builtin_amdgcn_s_barrier(); asm volatile("" ::: "memory"); } while (0)
__device__ __forceinline__ void gla_pre_item(LAS unsigned char* lds, int item, const bf16* XB, const bf16* Wfz, const float* SSQ, const bf16* Kb, const float* wfg2, const float* bfg, bf16* KDT, float* GAM) {
    const int tid = otid(), lane = tid & 63, w = __builtin_amdgcn_readfirstlane(tid >> 6), l15 = lane & 15, lq = lane >> 4;
    const int b = item >> 6, c = item & 63;
    const size_t row0 = (size_t)b * SEQ + (size_t)c * 64;
    LAS float* fzs = (LAS float*)lds;
    LAS float* tot = (LAS float*)(lds + 4096);
    LAS f32x4* part = (LAS f32x4*)(lds + 8192);
    LAS float* rsd = (LAS float*)(lds + 12288);
    const int kcol = tid & 127, tg = tid >> 7;
    { const float* sp = SSQ + (row0 + (tid >> 3)) * 16 + (tid & 7) * 2; float v = sp[0] + sp[1];
      v += __shfl_xor(v, 1); v += __shfl_xor(v, 2); v += __shfl_xor(v, 4);
      if ((tid & 7) == 0) rsd[tid >> 3] = __builtin_amdgcn_rsqf(v * (1.0f / 1024.0f) + 1e-6f); }
    float wfn[16]; float bfn; unsigned short kn[16];
#define PRE_LOAD(hh) do { _Pragma("unroll") for (int r = 0; r < 16; ++r) wfn[r] = wfg2[r * 512 + (hh) * 128 + kcol]; bfn = bfg[(hh) * 128 + kcol]; \
        const bf16* kp_ = Kb + (row0 + tg * 16) * 512 + (hh) * 128 + kcol; _Pragma("unroll") for (int i = 0; i < 16; ++i) kn[i] = kp_[i * 512]; } while (0)
    PRE_LOAD(0);
    { const int mt = w & 3, kh = w >> 2; f32x4 acc = (f32x4){0.f, 0.f, 0.f, 0.f};
      const bf16* ap = XB + (row0 + 16 * mt + l15) * 1024 + 512 * kh + 8 * lq; const bf16* bp = Wfz + (size_t)l15 * 1024 + 512 * kh + 8 * lq;
#pragma unroll
      for (int ks = 0; ks < 16; ++ks) acc = __builtin_amdgcn_mfma_f32_16x16x32_bf16(*(const bf16x8*)(ap + 32 * ks), *(const bf16x8*)(bp + 32 * ks), acc, 0, 0, 0);
      if (kh == 1) part[mt * 64 + lane] = acc;
      LDS_BAR();
      if (kh == 0) { const f32x4 o = part[mt * 64 + lane] + acc;
#pragma unroll
          for (int r = 0; r < 4; ++r) { const int tok = 16 * mt + 4 * lq + r; fzs[tok * 16 + l15] = o[r] * rsd[tok]; } }
      LDS_BAR(); }
#pragma unroll 1
    for (int h = 0; h < 4; ++h) {
        const int it = ((b * 4 + h) << 6) + c;
        float wf[16]; unsigned short kc[16];
#pragma unroll
        for (int r = 0; r < 16; ++r) { wf[r] = wfn[r]; kc[r] = kn[r]; }
        const float bf = bfn;
        { const int hn = (h < 3) ? h + 1 : 3; PRE_LOAD(hn); }
        float cum[16]; float run = 0.f;
#pragma unroll
        for (int i = 0; i < 16; ++i) { const LAS f32x4* z = (const LAS f32x4*)(fzs + (tg * 16 + i) * 16); float f = bf;
#pragma unroll
            for (int r4 = 0; r4 < 4; ++r4) { const f32x4 zz = z[r4]; f += zz.x * wf[4 * r4] + zz.y * wf[4 * r4 + 1] + zz.z * wf[4 * r4 + 2] + zz.w * wf[4 * r4 + 3]; }
            const float la = (fminf(f, 0.f) - __logf(1.0f + __expf(-fabsf(f)))) * (1.0f / 16.0f);
            run += la; cum[i] = run; }
        tot[tg * 128 + kcol] = run;
        LDS_BAR();
        float pre = 0.f, all = 0.f;
#pragma unroll
        for (int g = 0; g < 4; ++g) { const float tv = tot[g * 128 + kcol]; all += tv; if (g < tg) pre += tv; }
        unsigned pk[8];
#pragma unroll
        for (int i = 0; i < 8; ++i) { const float e0 = __expf(all - (pre + cum[2 * i])), e1 = __expf(all - (pre + cum[2 * i + 1]));
            pk[i] = pk2(__uint_as_float((unsigned)kc[2 * i] << 16) * e0, __uint_as_float((unsigned)kc[2 * i + 1] << 16) * e1); }
        v4u* dst = (v4u*)(KDT + (size_t)it * 8192 + kcol * 64 + tg * 16);
        dst[0] = (v4u){pk[0], pk[1], pk[2], pk[3]}; dst[1] = (v4u){pk[4], pk[5], pk[6], pk[7]};
        if (tg == 0) GAM[(size_t)it * 128 + kcol] = __expf(all);
        LDS_BAR();
    }
#undef PRE_LOAD
}

__device__ __forceinline__ void gla_scan_item(LAS unsigned char* lds, int item, const bf16* Qb, const bf16* Vb, bf16* Ob, const bf16* KDT, const float* GAM, float* GSSQ) {
    const int tid = otid(), lane = tid & 63, w = __builtin_amdgcn_readfirstlane(tid >> 6);
    const int b = item >> 5, h = (item >> 3) & 3, vs = item & 7, bh = b * 4 + h;
    const size_t rb = (size_t)b * SEQ;
    LAS unsigned char* vt = lds;
    LAS unsigned char* st = lds + 4608;
    LAS unsigned char* kdt = lds + 13312;
    LAS unsigned char* qt = lds + 31744;
    f32x4 S0 = (f32x4){0.f, 0.f, 0.f, 0.f}, S1 = (f32x4){0.f, 0.f, 0.f, 0.f};
    const int mt = w >> 1, nt = w & 1, l15 = lane & 15, lq = lane >> 4;
    const int vtok = tid >> 3, vc4 = (tid & 7) * 4;
    const bf16* kdp = KDT + (size_t)bh * 64 * 8192 + (size_t)tid * 8;
    const bf16* qp = Qb + (rb + (tid >> 4)) * 512 + h * 128 + (tid & 15) * 8;
    const float* gp = GAM + (size_t)bh * 64 * 128 + 16 * w + 4 * lq;
    const bf16* vp = Vb + (rb + vtok) * 1024 + h * 256 + vs * 32 + vc4;
    const int kd_dst = (tid >> 3) * 144 + (tid & 7) * 16, q_dst = (tid >> 4) * 272 + (tid & 15) * 16;
    v4u KA[4][2], QA[4][2]; f32x4 G4[4]; v2u VN[4];
#define GLA_LOAD(j, c) do { KA[j][0] = *(const v4u*)(kdp + (size_t)(c) * 8192); KA[j][1] = *(const v4u*)(kdp + (size_t)(c) * 8192 + 4096); \
        QA[j][0] = *(const v4u*)(qp + (size_t)(c) * 64 * 512); QA[j][1] = *(const v4u*)(qp + (size_t)(c) * 64 * 512 + 32 * 512); \
        G4[j] = *(const f32x4*)(gp + (size_t)(c) * 128); VN[j] = *(const v2u*)(vp + (size_t)(c) * 64 * 1024); } while (0)
#pragma unroll
    for (int j = 0; j < 4; ++j) GLA_LOAD(j, j);
#pragma unroll 1
    for (int c0 = 0; c0 < 64; c0 += 4) {
#pragma unroll
        for (int j = 0; j < 4; ++j) {
            const int c = c0 + j; LAS unsigned char* qtc = qt + (j & 1) * 17408;
            { LAS unsigned short* vts = (LAS unsigned short*)vt; const v2u vc = VN[j];
              vts[(vc4 + 0) * 72 + vtok] = (unsigned short)(vc.x & 0xffffu); vts[(vc4 + 1) * 72 + vtok] = (unsigned short)(vc.x >> 16);
              vts[(vc4 + 2) * 72 + vtok] = (unsigned short)(vc.y & 0xffffu); vts[(vc4 + 3) * 72 + vtok] = (unsigned short)(vc.y >> 16);
              *(LAS v4u*)(kdt + kd_dst) = KA[j][0]; *(LAS v4u*)(kdt + kd_dst + 64 * 144) = KA[j][1];
              *(LAS v4u*)(qtc + q_dst) = QA[j][0]; *(LAS v4u*)(qtc + q_dst + 32 * 272) = QA[j][1]; }
            const f32x4 g4 = G4[j];
            { const int cn = (c + 4 < 64) ? c + 4 : 63; GLA_LOAD(j, cn); }
            LDS_BAR();
            { S0 = S0 * g4; S1 = S1 * g4;
#pragma unroll
              for (int ks = 0; ks < 2; ++ks) {
                  const bf16x8 a = *(const LAS bf16x8*)(kdt + (16 * w + l15) * 144 + (8 * lq + 32 * ks) * 2);
                  const bf16x8 b0 = *(const LAS bf16x8*)(vt + l15 * 144 + (8 * lq + 32 * ks) * 2);
                  const bf16x8 b1 = *(const LAS bf16x8*)(vt + (16 + l15) * 144 + (8 * lq + 32 * ks) * 2);
                  S0 = __builtin_amdgcn_mfma_f32_16x16x32_bf16(a, b0, S0, 0, 0, 0);
                  S1 = __builtin_amdgcn_mfma_f32_16x16x32_bf16(a, b1, S1, 0, 0, 0); }
              *(LAS v2u*)(st + l15 * 272 + (16 * w + 4 * lq) * 2) = (v2u){pk2(S0[0], S0[1]), pk2(S0[2], S0[3])};
              *(LAS v2u*)(st + (16 + l15) * 272 + (16 * w + 4 * lq) * 2) = (v2u){pk2(S1[0], S1[1]), pk2(S1[2], S1[3])}; }
            LDS_BAR();
            { f32x4 o = (f32x4){0.f, 0.f, 0.f, 0.f};
#pragma unroll
              for (int ks = 0; ks < 4; ++ks) { const bf16x8 sa = *(const LAS bf16x8*)(st + (16 * nt + l15) * 272 + (8 * lq + 32 * ks) * 2);
                  const bf16x8 qb = *(const LAS bf16x8*)(qtc + (16 * mt + l15) * 272 + (8 * lq + 32 * ks) * 2);
                  o = __builtin_amdgcn_mfma_f32_16x16x32_bf16(sa, qb, o, 0, 0, 0); }
              const size_t row = rb + (size_t)c * 64 + 16 * mt + l15;
              *(v2u*)(Ob + row * 1024 + h * 256 + vs * 32 + 16 * nt + 4 * lq) = (v2u){pk2(o[0], o[1]), pk2(o[2], o[3])};
              float ss = (o[0] * o[0] + o[1] * o[1]) + (o[2] * o[2] + o[3] * o[3]);
              ss += __shfl_xor(ss, 16); ss += __shfl_xor(ss, 32);
              GSSQ[(size_t)(h * 16 + vs * 2 + nt) * M + row] = ss; }
        }
    }
#undef GLA_LOAD
    __syncthreads();
}

__device__ __forceinline__ int fill_rstd(LAS unsigned char* lds, const float* ssq, const pg8::StaticOrder& S) {
    pg8::Unit u0; u0.pm = 0; u0.pn = 0; (void)S.next(0, u0);
    const int tid = otid(); LAS float* tab = (LAS float*)(lds + 131072 + 1024);
    float v[4];
#pragma unroll
    for (int s = 0; s < 4; ++s) { const int pm = (u0.pm + 8 * s < M / 256) ? u0.pm + 8 * s : M / 256 - 1;
        const f32x4* p = (const f32x4*)(ssq + ((size_t)pm * 256 + (tid >> 1)) * 16 + (tid & 1) * 8);
        const f32x4 a = p[0], b = p[1]; v[s] = ((a.x + a.y) + (a.z + a.w)) + ((b.x + b.y) + (b.z + b.w)); }
#pragma unroll
    for (int s = 0; s < 4; ++s) { float t = v[s]; t += __shfl_xor(t, 1);
        if ((tid & 1) == 0) tab[s * 256 + (tid >> 1)] = __builtin_amdgcn_rsqf(t * (1.0f / 1024.0f) + 1e-6f); }
    __syncthreads();
    return u0.pm;
}
#define RTAB(pm0) pg8::RTab{(const LAS float*)(lds + 131072 + 1024), (pm0)}

#ifndef RPT_P1
#define RPT_P1 1
#endif
#ifndef RPT_P4
#define RPT_P4 1
#endif
#ifndef RPT_P6
#define RPT_P6 1
#endif
#ifndef REPS
#define REPS 1
#endif
#define P4_FENCE() do { asm volatile("s_waitcnt vmcnt(0)" ::: "memory"); __builtin_amdgcn_fence(__ATOMIC_ACQUIRE, "agent"); asm volatile("s_waitcnt vmcnt(0)" ::: "memory"); __syncthreads(); } while (0)
#define WSP(T, off) ((T*)(WS_PTR() + (off)))
__global__ void __launch_bounds__(512, 2) fwd_mega(Args a) {
    extern __shared__ __attribute__((aligned(16))) unsigned char lds_raw[];
    cg::grid_group grid = cg::this_grid();
    LAS unsigned char* lds = (LAS unsigned char*)lds_raw;
#define TID (otid())
#define LANE (TID & 63)
#define WAVE (__builtin_amdgcn_readfirstlane(TID >> 6))
#define GDIM (ogdim())
#define BX (obx())
#define VCU ((GDIM % 8 == 0) ? (BX % 8) * (GDIM / 8) + BX / 8 : BX)
#define GW (VCU * 8 + WAVE)
#define NGW (GDIM * 8)

    for (int u = TID; u < (LDS_BYTES - 131072) / 4; u += 512) ((LAS unsigned*)(lds + 131072))[u] = 0u;
    __syncthreads();
    (void)xcd_barrier_post((unsigned*)(WS_PTR() + 16384), (volatile LAS unsigned*)(lds + 131072 + 352));
#define GRID_SYNC() do { XcdBarrier b_; b_.bar = (unsigned*)(WS_PTR() + 16384); b_.x = xb_xcc_id(); b_.st = (volatile LAS unsigned*)(lds + 131072 + 352); xcd_barrier(b_); } while (0)
#pragma unroll 1
    for (int rep = 0; rep < REPS; ++rep) {
#ifndef SKIP_P0
    {
        const int lane = LANE, gw = GW, ngw = NGW;
        unsigned char* ws = WS_PTR();
        LAS float* scr = (LAS float*)(lds + WAVE * 16384);
        constexpr int I_IN = 16 * 264, I_SQ = 512, I_GU = 16 * 176, I_D = 44 * 32, I_L = I_IN + 3 * I_SQ + I_GU + I_D;
        for (int it = gw; it < 2 * I_L; it += ngw) {
            const int l = it / I_L; int r = it % I_L; unsigned char* wb = ws + WS_W0 + (size_t)l * WS_WL;
            if (r < I_IN) { const int kb = r / 264, nb = r % 264; tr_item(IN_PTR(2) + (size_t)l * D * NIN, NIN, in_src_col(nb * 32 + (lane & 31)), IN_PTR(1) + l * D, (bf16*)(wb + WO_IN), D, nb * 32, kb * 64, scr, lane); continue; }
            r -= I_IN;
            if (r < 3 * I_SQ) { const int which = r / I_SQ, r2 = r % I_SQ, kb = r2 / 32, nb = r2 % 32; const float* src = (which == 0 ? IN_PTR(6) : which == 1 ? IN_PTR(9) : IN_PTR(10)) + (size_t)l * D * D;
                tr_item(src, D, nb * 32 + (lane & 31), nullptr, (bf16*)(wb + WO_OA + (size_t)which * 2 * MiB), D, nb * 32, kb * 64, scr, lane); continue; }
            r -= 3 * I_SQ;
            if (r < I_GU) { const int kb = r / 176, nb = r % 176, d0 = nb * 32, j = d0 >> 8, i = d0 & 255; const float* src = (i >= 128 ? IN_PTR(13) : IN_PTR(12)) + (size_t)l * D * FF;
                tr_item(src, FF, 128 * j + (i & 127) + (lane & 31), IN_PTR(11) + l * D, (bf16*)(wb + WO_GU), D, d0, kb * 64, scr, lane); continue; }
            r -= I_GU;
            { const int kb = r / 32, nb = r % 32; tr_item(IN_PTR(14) + (size_t)l * FF * D, D, nb * 32 + (lane & 31), nullptr, (bf16*)(wb + WO_D), FF, nb * 32, kb * 64, scr, lane); }
        }
        const float* x = IN_PTR(0); bf16* XB = (bf16*)(ws + WS_XB); float* SSQ = (float*)(ws + WS_SSQ);
        for (int m = 4 * gw; m < M; m += 4 * ngw) {
            f32x4 v[4][4]; float s[4];
#pragma unroll
            for (int r = 0; r < 4; ++r)
#pragma unroll
                for (int j = 0; j < 4; ++j) v[r][j] = ((const f32x4*)(x + (size_t)(m + r) * D) + lane)[64 * j];
#pragma unroll
            for (int r = 0; r < 4; ++r) { float t = 0.f;
#pragma unroll
                for (int j = 0; j < 4; ++j) t += (v[r][j].x * v[r][j].x + v[r][j].y * v[r][j].y) + (v[r][j].z * v[r][j].z + v[r][j].w * v[r][j].w);
                s[r] = wave_sum(t); }
#pragma unroll
            for (int r = 0; r < 4; ++r) { unsigned long long* o8 = (unsigned long long*)(XB + (size_t)(m + r) * D) + lane;
#pragma unroll
                for (int j = 0; j < 4; ++j) o8[64 * j] = (unsigned long long)pk2(v[r][j].x, v[r][j].y) | ((unsigned long long)pk2(v[r][j].z, v[r][j].w) << 32); }
            SSQ[(size_t)m * 16 + lane] = (lane == 0) ? s[0] : (lane == 16) ? s[1] : (lane == 32) ? s[2] : (lane == 48) ? s[3] : 0.f;
        }
    }
#endif
    asm volatile("s_waitcnt vmcnt(0)" ::: "memory"); grid.sync();
    GRID_SYNC();

#pragma unroll 1
    for (int l = 0; l < 2; ++l) {
#ifndef SKIP_P1
        for (int rp = 0; rp < RPT_P1; ++rp) { unsigned char* ws = WS_PTR();
          pg8::Gemm g{(const bf16*)(ws + WS_XB), (const bf16*)(ws + WS_W0 + (size_t)l * WS_WL + WO_IN), M, 5120, D}; pg8::P1Order S; S.init(M, 5120, GDIM, BX); const int pm0 = fill_rstd(lds, (const float*)(ws + WS_SSQ), S);
          pg8::EpiInProj E{(bf16*)(ws + WS_Q), (bf16*)(ws + WS_K), (bf16*)(ws + WS_V), (bf16*)(ws + WS_R), (bf16*)(ws + WS_U), (bf16*)(ws + WS_GBIN), (float*)(ws + WS_FZ), RTAB(pm0)};
          pg8::gemm_phase<pg8::EpiInProj, pg8::P1Order, true, true>(lds, g, S, E); }
#endif
        GRID_SYNC();
#ifndef SKIP_GLA
        { unsigned char* ws = WS_PTR();
          for (int item = VCU; item < 512; item += GDIM)
              gla_pre_item(lds, item, (const bf16*)(ws + WS_XB), (const bf16*)(ws + WS_W0 + (size_t)l * WS_WL + WO_IN) + (size_t)6144 * D, (const float*)(ws + WS_SSQ), (const bf16*)(ws + WS_K),
                           IN_PTR(3) + (size_t)l * 16 * 512, IN_PTR(4) + l * 512, (bf16*)(ws + WS_KDT), (float*)(ws + WS_GAM)); }
#endif
#ifndef SKIP_CONV
        {
            const int lane = LANE, gw = GW, ngw = NGW;
            unsigned char* ws = WS_PTR(); const bf16* Ub = (const bf16*)(ws + WS_U); bf16* GBIN = (bf16*)(ws + WS_GBIN);
            const float* cw = IN_PTR(7) + (size_t)l * 3 * D; const float* cb = IN_PTR(8) + l * D;
            for (int run = gw; run < M / 8; run += ngw) {
                const int m0 = (run >> 1) * 16, c0 = (run & 1) * 512 + lane * 8;
                float w0[8], w1[8], w2[8], bb[8], um2[8], um1[8];
#pragma unroll
                for (int j = 0; j < 8; ++j) { w0[j] = cw[c0 + j]; w1[j] = cw[D + c0 + j]; w2[j] = cw[2 * D + c0 + j]; bb[j] = cb[c0 + j]; }
                if ((m0 & (SEQ - 1)) == 0) {
#pragma unroll
                    for (int j = 0; j < 8; ++j) { um2[j] = 0.f; um1[j] = 0.f; }
                } else { load8(Ub + (size_t)(m0 - 2) * D + c0, um2); load8(Ub + (size_t)(m0 - 1) * D + c0, um1); }
#pragma unroll 1
                for (int i0 = 0; i0 < 16; i0 += 4) {
                    v4u ur[4], gr[4];
#pragma unroll
                    for (int r = 0; r < 4; ++r) { const size_t off = (size_t)(m0 + i0 + r) * D + c0; ur[r] = *(const v4u*)(Ub + off); gr[r] = *(const v4u*)(GBIN + off); }
#pragma unroll
                    for (int r = 0; r < 4; ++r) { const size_t off = (size_t)(m0 + i0 + r) * D + c0; float u0[8], gg[8], o[8];
                        u0[0] = bflo(ur[r].x); u0[1] = bfhi(ur[r].x); u0[2] = bflo(ur[r].y); u0[3] = bfhi(ur[r].y); u0[4] = bflo(ur[r].z); u0[5] = bfhi(ur[r].z); u0[6] = bflo(ur[r].w); u0[7] = bfhi(ur[r].w);
                        gg[0] = bflo(gr[r].x); gg[1] = bfhi(gr[r].x); gg[2] = bflo(gr[r].y); gg[3] = bfhi(gr[r].y); gg[4] = bflo(gr[r].z); gg[5] = bfhi(gr[r].z); gg[6] = bflo(gr[r].w); gg[7] = bfhi(gr[r].w);
#pragma unroll
                        for (int j = 0; j < 8; ++j) { o[j] = gg[j] * (w0[j] * um2[j] + w1[j] * um1[j] + w2[j] * u0[j] + bb[j]); um2[j] = um1[j]; um1[j] = u0[j]; }
                        store8(GBIN + off, o); }
                }
            }
        }
#endif
        GRID_SYNC();
#ifdef PROBE_SCAN
        { unsigned char* ws = WS_PTR();
          for (int item = VCU; item < 256; item += GDIM)
              gla_scan_item(lds, item, (const bf16*)(ws + WS_Q), (const bf16*)(ws + WS_V), (bf16*)(ws + WS_R), (const bf16*)(ws + WS_KDT), (const float*)(ws + WS_GAM), (float*)(ws + WS_GSSQ)); }
#endif
#ifndef SKIP_GLA
        { unsigned char* ws = WS_PTR();
          for (int item = VCU; item < 256; item += GDIM)
              gla_scan_item(lds, item, (const bf16*)(ws + WS_Q), (const bf16*)(ws + WS_V), (bf16*)(ws + WS_V), (const bf16*)(ws + WS_KDT), (const float*)(ws + WS_GAM), (float*)(ws + WS_GSSQ)); }
#endif
        GRID_SYNC();
#ifndef SKIP_P4
        { unsigned char* ws = WS_PTR(); const bf16* Win = (const bf16*)(ws + WS_W0 + (size_t)l * WS_WL + WO_IN); const bf16* XBp = (const bf16*)(ws + WS_XB);
          pg8::Gemm4 g{XBp, XBp, XBp, XBp, Win + (size_t)2048 * D, Win + (size_t)NIN1 * D, Win + (size_t)(NIN1 + D) * D, Win + (size_t)(NIN1 + D) * D, M, D, D};
          pg8::ChainOrder S; S.init(M, D, GDIM, BX); S.tpw = (M / 256) * (D / 256) / GDIM; S.ns = 3; const int pm0 = fill_rstd(lds, (const float*)(ws + WS_SSQ), S);
          if (S.tpw * GDIM == (M / 256) * (D / 256)) {
          pg8::EpiX E{pg8::EpiO{(bf16*)(ws + WS_V), (const float*)(ws + WS_GSSQ), IN_PTR(5) + l * 256, RTAB(pm0)}, pg8::EpiGate{(bf16*)(ws + WS_GA), RTAB(pm0)}, pg8::EpiGate{(bf16*)(ws + WS_GB), RTAB(pm0)}};
          pg8::gemm_phase<pg8::EpiX, pg8::ChainOrder, true, true, pg8::Gemm4>(lds, g, S, E); } }
#endif
        GRID_SYNC();
#ifndef SKIP_P4
        { unsigned char* ws = WS_PTR();
          const bf16* Ao = (const bf16*)(ws + WS_V); const bf16* Ac = (const bf16*)(ws + WS_GBIN); const bf16* Ba = (const bf16*)(ws + WS_W0 + (size_t)l * WS_WL + WO_OA); const bf16* Bb = (const bf16*)(ws + WS_W0 + (size_t)l * WS_WL + WO_OB);
          pg8::Gemm4 g{Ao, Ac, Ac, Ac, Ba, Bb, Bb, Bb, M, D, D};
          pg8::ChainOrder S; S.init(M, D, GDIM, BX); S.tpw = (M / 256) * (D / 256) / GDIM; S.ns = 2;
          if (S.tpw * GDIM == (M / 256) * (D / 256)) {
          pg8::EpiY E{pg8::EpiMix<0>{(const bf16*)(ws + WS_GA), (bf16*)(ws + WS_GA)}, pg8::EpiMix<1>{(const bf16*)(ws + WS_GB), (bf16*)(ws + WS_GA)}};
          pg8::gemm_phase<pg8::EpiY, pg8::ChainOrder, true, true, pg8::Gemm4>(lds, g, S, E); } }
#endif
        GRID_SYNC();
#ifndef SKIP_P5
        { unsigned char* ws = WS_PTR();
          pg8::Gemm g{(const bf16*)(ws + WS_GA), (const bf16*)(ws + WS_W0 + (size_t)l * WS_WL + WO_O), M, D, D}; pg8::StaticOrder S; S.init(M, D, GDIM, BX);
          pg8::EpiRes E{(bf16*)(ws + WS_XB), (float*)(ws + WS_SSQ)};
          pg8::gemm_phase<pg8::EpiRes, pg8::StaticOrder, true, true>(lds, g, S, E); }
#endif
        GRID_SYNC();
#ifndef SKIP_P6
        for (int rp = 0; rp < RPT_P6; ++rp) { unsigned char* ws = WS_PTR();
          pg8::Gemm g{(const bf16*)(ws + WS_XB), (const bf16*)(ws + WS_W0 + (size_t)l * WS_WL + WO_GU), M, NGU, D}; pg8::StaticOrder S; S.init(M, NGU, GDIM, BX); const int pm0 = fill_rstd(lds, (const float*)(ws + WS_SSQ), S);
          pg8::EpiFfn1 E{(bf16*)(ws + WS_HID), RTAB(pm0)};
          pg8::gemm_phase<pg8::EpiFfn1, pg8::StaticOrder, true, true>(lds, g, S, E); }
#endif
        GRID_SYNC();
#ifndef SKIP_P7
        { unsigned char* ws = WS_PTR();
          pg8::Gemm g{(const bf16*)(ws + WS_HID), (const bf16*)(ws + WS_W0 + (size_t)l * WS_WL + WO_D), M, D, FF}; pg8::StaticOrder S; S.init(M, D, GDIM, BX);
          pg8::EpiRes E{(bf16*)(ws + WS_XB), (float*)(ws + WS_SSQ)};
          pg8::gemm_phase<pg8::EpiRes, pg8::StaticOrder, true, true>(lds, g, S, E); }
#endif
        GRID_SYNC();
    }
    {
        const int lane = LANE, gw = GW, ngw = NGW;
        float* out = OUT_PTR(); const float* SSQ = (const float*)(WS_PTR() + WS_SSQ); const bf16* XB = (const bf16*)(WS_PTR() + WS_XB);
        float g[16];
#pragma unroll
        for (int j = 0; j < 16; ++j) g[j] = IN_PTR(15)[lane * 16 + j];
        for (int m = 4 * gw; m < M; m += 4 * ngw) {
            float s[4]; v4u xa[4], xb[4];
#pragma unroll
            for (int r = 0; r < 4; ++r) { s[r] = SSQ[(size_t)(m + r) * 16 + (lane & 15)]; xa[r] = *(const v4u*)(XB + (size_t)(m + r) * D + lane * 16); xb[r] = *(const v4u*)(XB + (size_t)(m + r) * D + lane * 16 + 8); }
#pragma unroll
            for (int r = 0; r < 4; ++r) { float t = (lane < 16) ? s[r] : 0.f; t = wave_sum(t);
                const float rstd = __builtin_amdgcn_rsqf(t * (1.0f / 1024.0f) + 1e-6f);
                float v[16];
                v[0] = bflo(xa[r].x); v[1] = bfhi(xa[r].x); v[2] = bflo(xa[r].y); v[3] = bfhi(xa[r].y); v[4] = bflo(xa[r].z); v[5] = bfhi(xa[r].z); v[6] = bflo(xa[r].w); v[7] = bfhi(xa[r].w);
                v[8] = bflo(xb[r].x); v[9] = bfhi(xb[r].x); v[10] = bflo(xb[r].y); v[11] = bfhi(xb[r].y); v[12] = bflo(xb[r].z); v[13] = bfhi(xb[r].z); v[14] = bflo(xb[r].w); v[15] = bfhi(xb[r].w);
                f32x4* o = (f32x4*)(out + (size_t)(m + r) * D + lane * 16);
#pragma unroll
                for (int j = 0; j < 4; ++j) o[j] = (f32x4){v[4 * j] * rstd * g[4 * j], v[4 * j + 1] * rstd * g[4 * j + 1], v[4 * j + 2] * rstd * g[4 * j + 2], v[4 * j + 3] * rstd * g[4 * j + 3]}; }
        }
    }
    GRID_SYNC();
    }
}

extern "C" void kernel_launch(void* const* d_in, const int* in_sizes, int n_in, void* d_out, int out_size, void* d_ws, size_t ws_size, hipStream_t stream) {
    static int grid = 0;
    if (grid == 0) {
        if (n_in != 16 || in_sizes[0] != M * D || out_size != M * D || ws_size < WS_END) { fprintf(stderr, "kernel_launch: unexpected shapes / workspace (n_in %d, ws %zu)\n", n_in, ws_size); grid = -1; return; }
        int dev = 0, cus = 0, per_cu = 0;
        if (hipGetDevice(&dev) != hipSuccess || hipDeviceGetAttribute(&cus, hipDeviceAttributeMultiprocessorCount, dev) != hipSuccess) { grid = -1; return; }
        if (hipFuncSetAttribute((const void*)fwd_mega, hipFuncAttributeMaxDynamicSharedMemorySize, LDS_BYTES) != hipSuccess) { fprintf(stderr, "kernel_launch: hipFuncSetAttribute failed\n"); grid = -1; return; }
        if (hipOccupancyMaxActiveBlocksPerMultiprocessor(&per_cu, (const void*)fwd_mega, 512, LDS_BYTES) != hipSuccess || per_cu < 1) { fprintf(stderr, "kernel_launch: occupancy query says %d blocks per CU\n", per_cu); per_cu = 1; }
        (void)hipGetLastError();
        grid = cus;
    }
    if (grid < 0) return;
    if (hipMemsetAsync(d_ws, 0, 1 << 20, stream) != hipSuccess) { fprintf(stderr, "kernel_launch: memset of the control words failed\n"); return; }
    Args a{};
    for (int i = 0; i < 16; ++i) a.in[i] = (const float*)d_in[i];
    a.out = (float*)d_out; a.ws = (unsigned char*)d_ws;
    void* args[] = {&a};
    hipError_t e = hipLaunchCooperativeKernel((const void*)fwd_mega, dim3(grid), dim3(512), args, LDS_BYTES, stream);
    if (e != hipSuccess) fprintf(stderr, "kernel_launch: cooperative launch failed: %s (grid %d)\n", hipGetErrorString(e), grid);
}
```

```cpp
#include <hip/hip_runtime.h>
#include <hip/hip_cooperative_groups.h>
#include <cstdio>
#include <cstdint>
namespace cg = cooperative_groups;
namespace pg8 {
#define PG8_LAS __attribute__((address_space(3)))
typedef unsigned short bf16_t;
typedef short bf16x8 __attribute__((ext_vector_type(8)));
typedef float f32x4 __attribute__((ext_vector_type(4)));
typedef unsigned u32x4 __attribute__((ext_vector_type(4)));
constexpr int BM = 256, BK = 64, HALF = 128, HTB = HALF * BK * 2  , STAGE_BYTES = 8 * HTB, NXCD = 8, WGM = 8;

__host__ __device__ __forceinline__ int lds_byte(int r, int c) { const int st = (r >> 4) * 2 + (c >> 5), rr = r & 15, cc = c & 31, ob = rr * 64 + cc * 2; return st * 1024 + (ob ^ (((ob >> 9) & 1) << 5)); }
__host__ __device__ __forceinline__ void stage_rc(int b, int& R, int& C) { const int st = b / 1024, sb = b % 1024, swz = sb ^ (((sb >> 9) & 1) << 5); R = (st >> 1) * 16 + swz / 64; C = (st & 1) * 32 + (swz % 64) / 2; }
__host__ __device__ __forceinline__ int perm32(int rho) { const int n = rho >> 4, i = rho & 15; return 8 * (i >> 2) + 4 * n + (i & 3); }

struct Unit { int pm, pn, st; };
struct Gemm { const bf16_t* A; const bf16_t* Bt; int M, N, K;
    __device__ __forceinline__ const bf16_t* a_of(const Unit&) const { return A; } __device__ __forceinline__ const bf16_t* b_of(const Unit&) const { return Bt; } };
struct Gemm4 { const bf16_t *A0, *A1, *A2, *A3, *B0, *B1, *B2, *B3; int M, N, K;
    __device__ __forceinline__ const bf16_t* a_of(const Unit& u) const { return u.st == 0 ? A0 : u.st == 1 ? A1 : u.st == 2 ? A2 : A3; }
    __device__ __forceinline__ const bf16_t* b_of(const Unit& u) const { return u.st == 0 ? B0 : u.st == 1 ? B1 : u.st == 2 ? B2 : B3; } };

struct StaticOrder {
    int nM, nN, nwg, G, c;
    __host__ __device__ void init(int M, int N, int G_, int c_) { nM = M / BM; nN = N / BM; nwg = nM * nN; G = G_; c = c_; }
    __host__ __device__ bool next(int i, Unit& u) const {
        const long L = (long)i * G + c; if (L >= nwg) return false;
        int wgid = (int)L; { const int q = nwg / NXCD, r = nwg % NXCD, xcd = wgid % NXCD, off = wgid / NXCD; wgid = (xcd < r ? xcd * (q + 1) : r * (q + 1) + (xcd - r) * q) + off; }
        const int nig = WGM * nN, gid = wgid / nig, fm = gid * WGM, gsz = (nM - fm) < WGM ? (nM - fm) : WGM;
        u.pm = fm + ((wgid % nig) % gsz); u.pn = (wgid % nig) / gsz; u.st = 0; return true;
    }
    __device__ __forceinline__ void a_ready(const Unit&) const {}
    __device__ __forceinline__ void done(const Unit&) const {}
};

struct ChainOrder : StaticOrder { int tpw, ns;
    __device__ bool next(int i, Unit& u) const { if (i >= ns * tpw) return false; const bool ok = StaticOrder::next(i / ns, u); u.st = i % ns; return ok; } };
struct P1Order : StaticOrder {
    __device__ bool next(int i, Unit& u) const { const bool ok = StaticOrder::next(i, u); if (u.pn >= 8) u.pn += 4; return ok; } };

typedef float f32x2_t __attribute__((ext_vector_type(2))); typedef __bf16 bf16x2_t __attribute__((ext_vector_type(2)));
__device__ __forceinline__ unsigned cvt_pk_bf16(float lo, float hi) { f32x2_t v = {lo, hi}; bf16x2_t b = __builtin_convertvector(v, bf16x2_t); return __builtin_bit_cast(unsigned, b); }
typedef float f32x2 __attribute__((ext_vector_type(2)));
typedef unsigned u32x2 __attribute__((ext_vector_type(2)));
__device__ __forceinline__ float bf_lo(unsigned w) { return __uint_as_float(w << 16); }
__device__ __forceinline__ float bf_hi(unsigned w) { return __uint_as_float(w & 0xffff0000u); }
__device__ __forceinline__ float fsigmoid(float x) { return __builtin_amdgcn_rcpf(1.0f + __expf(-x)); }
struct RTab { const PG8_LAS float* tab; int pm0; };
#define EPI_ROWS(rs, rt, u, wr, fr) float rs[2][4]; { const PG8_LAS float* rp_ = (rt).tab + (((u).pm - (rt).pm0) >> 3) * 256 + (wr) * 64 + (fr); \
    _Pragma("unroll") for (int ai = 0; ai < 2; ++ai) _Pragma("unroll") for (int m = 0; m < 4; ++m) rs[ai][m] = rp_[ai * HALF + m * 16]; }

struct EpiInProj {
    static constexpr bool PERM = true, AFTER_DRAIN = false;
    bf16_t *Q, *Kb, *V, *R, *U, *GBIN; float* FZ; RTab rt;
    __device__ __forceinline__ void operator()(const f32x4 (&acc)[2][2][4][2], const Unit& u, int wr, int wc, int fr, int fq) const {
        const int row0 = u.pm * BM + wr * 64 + fr, pn = u.pn;
        EPI_ROWS(rs, rt, u, wr, fr)
        if (pn >= 12 && pn < 20) {
            const int col0 = (pn - 12) * 128 + wc * 32 + 8 * fq;
#pragma unroll
            for (int ai = 0; ai < 2; ++ai)
#pragma unroll
                for (int m = 0; m < 4; ++m) { const float s = rs[ai][m] * rs[ai][m];
                    const f32x4 v0 = acc[ai][0][m][0] * acc[ai][1][m][0] * s, v1 = acc[ai][0][m][1] * acc[ai][1][m][1] * s;
                    u32x4 w; w.x = cvt_pk_bf16(v0[0], v0[1]); w.y = cvt_pk_bf16(v0[2], v0[3]); w.z = cvt_pk_bf16(v1[0], v1[1]); w.w = cvt_pk_bf16(v1[2], v1[3]);
                    *(u32x4*)(U + (size_t)(row0 + ai * HALF + m * 16) * 1024 + col0) = w; }
        } else if (pn == 24) {
            if (wc == 0 && fq < 2) {
#pragma unroll
                for (int ai = 0; ai < 2; ++ai)
#pragma unroll
                    for (int m = 0; m < 4; ++m) { float* p = FZ + (size_t)(row0 + ai * HALF + m * 16) * 16 + 8 * fq;
                        *(f32x4*)p = acc[ai][0][m][0] * rs[ai][m]; *(f32x4*)(p + 4) = acc[ai][0][m][1] * rs[ai][m]; }
            }
        } else {
            bf16_t* base; int ldc, colt; float sc = 1.0f;
            if (pn < 2) { base = Q; ldc = 512; colt = pn * 256; sc = 0.08838834764831845f; }
            else if (pn < 4) { base = Kb; ldc = 512; colt = (pn - 2) * 256; }
            else if (pn < 8) { base = V; ldc = 1024; colt = (pn - 4) * 256; }
            else if (pn < 12) { base = R; ldc = 1024; colt = (pn - 8) * 256; }
            else { base = GBIN; ldc = 1024; colt = (pn - 20) * 256; }
            const int col0 = colt + wc * 32 + 8 * fq;
#pragma unroll
            for (int ai = 0; ai < 2; ++ai)
#pragma unroll
                for (int m = 0; m < 4; ++m) { const float s = rs[ai][m] * sc; bf16_t* rowp = base + (size_t)(row0 + ai * HALF + m * 16) * ldc + col0;
#pragma unroll
                    for (int bj = 0; bj < 2; ++bj) { const f32x4 v0 = acc[ai][bj][m][0] * s, v1 = acc[ai][bj][m][1] * s;
                        u32x4 w; w.x = cvt_pk_bf16(v0[0], v0[1]); w.y = cvt_pk_bf16(v0[2], v0[3]); w.z = cvt_pk_bf16(v1[0], v1[1]); w.w = cvt_pk_bf16(v1[2], v1[3]);
                        *(u32x4*)(rowp + bj * HALF) = w; } }
        }
    }
};
struct EpiGate {
    static constexpr bool PERM = true, AFTER_DRAIN = false;
    bf16_t* G; RTab rt;
    __device__ __forceinline__ void operator()(const f32x4 (&acc)[2][2][4][2], const Unit& u, int wr, int wc, int fr, int fq) const {
        const int row0 = u.pm * BM + wr * 64 + fr, col0 = u.pn * BM + wc * 32 + 8 * fq;
        EPI_ROWS(rs, rt, u, wr, fr)
#pragma unroll
        for (int ai = 0; ai < 2; ++ai)
#pragma unroll
            for (int m = 0; m < 4; ++m) { const float s = rs[ai][m]; bf16_t* rowp = G + (size_t)(row0 + ai * HALF + m * 16) * 1024 + col0;
#pragma unroll
                for (int bj = 0; bj < 2; ++bj) { const f32x4 v0 = acc[ai][bj][m][0] * s, v1 = acc[ai][bj][m][1] * s;
                    u32x4 w; w.x = cvt_pk_bf16(fsigmoid(v0[0]), fsigmoid(v0[1])); w.y = cvt_pk_bf16(fsigmoid(v0[2]), fsigmoid(v0[3]));
                    w.z = cvt_pk_bf16(fsigmoid(v1[0]), fsigmoid(v1[1])); w.w = cvt_pk_bf16(fsigmoid(v1[2]), fsigmoid(v1[3]));
                    *(u32x4*)(rowp + bj * HALF) = w; } }
    }
};
template <int ADD> struct EpiMix {
    static constexpr bool PERM = true, AFTER_DRAIN = false;
    const bf16_t* G; bf16_t* MIX;
    __device__ __forceinline__ void operator()(const f32x4 (&acc)[2][2][4][2], const Unit& u, int wr, int wc, int fr, int fq) const {
        const int row0 = u.pm * BM + wr * 64 + fr, col0 = u.pn * BM + wc * 32 + 8 * fq;
#pragma unroll
        for (int ai = 0; ai < 2; ++ai) {
            u32x4 g[4][2], o[4][2];
#pragma unroll
            for (int m = 0; m < 4; ++m)
#pragma unroll
                for (int bj = 0; bj < 2; ++bj) { const size_t off = (size_t)(row0 + ai * HALF + m * 16) * 1024 + col0 + bj * HALF;
                    g[m][bj] = *(const u32x4*)(G + off); o[m][bj] = (u32x4){0u, 0u, 0u, 0u}; if (ADD) o[m][bj] = *(const u32x4*)(MIX + off); }
#pragma unroll
            for (int m = 0; m < 4; ++m)
#pragma unroll
                for (int bj = 0; bj < 2; ++bj) { const size_t off = (size_t)(row0 + ai * HALF + m * 16) * 1024 + col0 + bj * HALF;
                    const f32x4 a0 = acc[ai][bj][m][0], a1 = acc[ai][bj][m][1]; const u32x4 gg = g[m][bj], oo = o[m][bj];
                    u32x4 w;
                    w.x = cvt_pk_bf16(bf_lo(oo.x) + bf_lo(gg.x) * a0[0], bf_hi(oo.x) + bf_hi(gg.x) * a0[1]);
                    w.y = cvt_pk_bf16(bf_lo(oo.y) + bf_lo(gg.y) * a0[2], bf_hi(oo.y) + bf_hi(gg.y) * a0[3]);
                    w.z = cvt_pk_bf16(bf_lo(oo.z) + bf_lo(gg.z) * a1[0], bf_hi(oo.z) + bf_hi(gg.z) * a1[1]);
                    w.w = cvt_pk_bf16(bf_lo(oo.w) + bf_lo(gg.w) * a1[2], bf_hi(oo.w) + bf_hi(gg.w) * a1[3]);
                    *(u32x4*)(MIX + off) = w; }
            asm volatile("" ::: "memory"); }
    }
};
struct EpiRes {
    static constexpr bool PERM = true, AFTER_DRAIN = false;
    bf16_t* XB; float* ssq;
    __device__ __forceinline__ void operator()(const f32x4 (&acc)[2][2][4][2], const Unit& u, int wr, int wc, int fr, int fq) const {
        const int row0 = u.pm * BM + wr * 64 + fr, col0 = u.pn * BM + wc * 32 + 8 * fq;
#pragma unroll
        for (int ai = 0; ai < 2; ++ai) {
            u32x4 xi[4][2];
#pragma unroll
            for (int m = 0; m < 4; ++m)
#pragma unroll
                for (int bj = 0; bj < 2; ++bj) xi[m][bj] = *(const u32x4*)(XB + (size_t)(row0 + ai * HALF + m * 16) * 1024 + col0 + bj * HALF);
#pragma unroll
            for (int m = 0; m < 4; ++m) { const int row = row0 + ai * HALF + m * 16; float q = 0.f;
#pragma unroll
                for (int bj = 0; bj < 2; ++bj) { const size_t off = (size_t)row * 1024 + col0 + bj * HALF; const u32x4 x = xi[m][bj]; const f32x4 a0 = acc[ai][bj][m][0], a1 = acc[ai][bj][m][1];
                    u32x4 w; w.x = cvt_pk_bf16(bf_lo(x.x) + a0[0], bf_hi(x.x) + a0[1]); w.y = cvt_pk_bf16(bf_lo(x.y) + a0[2], bf_hi(x.y) + a0[3]);
                    w.z = cvt_pk_bf16(bf_lo(x.z) + a1[0], bf_hi(x.z) + a1[1]); w.w = cvt_pk_bf16(bf_lo(x.w) + a1[2], bf_hi(x.w) + a1[3]);
                    *(u32x4*)(XB + off) = w;
                    const float r0 = bf_lo(w.x), r1 = bf_hi(w.x), r2 = bf_lo(w.y), r3 = bf_hi(w.y), r4 = bf_lo(w.z), r5 = bf_hi(w.z), r6 = bf_lo(w.w), r7 = bf_hi(w.w);
                    q += ((r0 * r0 + r1 * r1) + (r2 * r2 + r3 * r3)) + ((r4 * r4 + r5 * r5) + (r6 * r6 + r7 * r7)); }
                q += __shfl_xor(q, 16); q += __shfl_xor(q, 32);
                if (fq == 0) ssq[(size_t)row * 16 + u.pn * 4 + wc] = q; }
            asm volatile("" ::: "memory"); }
    }
};
struct EpiFfn1 {
    static constexpr bool PERM = true, AFTER_DRAIN = false;
    bf16_t* HID; RTab rt;
    __device__ __forceinline__ void operator()(const f32x4 (&acc)[2][2][4][2], const Unit& u, int wr, int wc, int fr, int fq) const {
        const int row0 = u.pm * BM + wr * 64 + fr, col0 = u.pn * 128 + wc * 32 + 8 * fq;
        EPI_ROWS(rs, rt, u, wr, fr)
#pragma unroll
        for (int ai = 0; ai < 2; ++ai)
#pragma unroll
            for (int m = 0; m < 4; ++m) { const float s = rs[ai][m]; float h[8];
#pragma unroll
                for (int n = 0; n < 2; ++n)
#pragma unroll
                    for (int j = 0; j < 4; ++j) { const float g = acc[ai][0][m][n][j] * s, up = acc[ai][1][m][n][j] * s; h[4 * n + j] = g * fsigmoid(g) * up; }
                u32x4 w; w.x = cvt_pk_bf16(h[0], h[1]); w.y = cvt_pk_bf16(h[2], h[3]); w.z = cvt_pk_bf16(h[4], h[5]); w.w = cvt_pk_bf16(h[6], h[7]);
                *(u32x4*)(HID + (size_t)(row0 + ai * HALF + m * 16) * 2816 + col0) = w; }
    }
};

struct EpiO {
    static constexpr bool PERM = true, AFTER_DRAIN = false;
    bf16_t* V; const float* gssq; const float* gn; RTab rt;
    __device__ __forceinline__ void operator()(const f32x4 (&acc)[2][2][4][2], const Unit& u, int wr, int wc, int fr, int fq) const {
        const int row0 = u.pm * BM + wr * 64 + fr, cw = wc * 32 + 8 * fq, col0 = u.pn * BM + cw;
        float hr[2][4];
        { f32x4 hs[2][4];
#pragma unroll
          for (int ai = 0; ai < 2; ++ai)
#pragma unroll
              for (int m = 0; m < 4; ++m) { const float* gq = gssq + (size_t)(u.pn * 16 + 4 * fq) * 32768 + (row0 + ai * HALF + m * 16);
                  hs[ai][m] = (f32x4){gq[0], gq[32768], gq[2 * 32768], gq[3 * 32768]}; }
#pragma unroll
          for (int ai = 0; ai < 2; ++ai)
#pragma unroll
              for (int m = 0; m < 4; ++m) { float t = (hs[ai][m].x + hs[ai][m].y) + (hs[ai][m].z + hs[ai][m].w); t += __shfl_xor(t, 16); t += __shfl_xor(t, 32);
                  hr[ai][m] = __builtin_amdgcn_rsqf(t * (1.0f / 256.0f) + 1e-6f); } }
        asm volatile("" ::: "memory");
        EPI_ROWS(rs, rt, u, wr, fr)
        f32x4 gv[2][2];
#pragma unroll
        for (int bj = 0; bj < 2; ++bj)
#pragma unroll
            for (int n = 0; n < 2; ++n) gv[bj][n] = *(const f32x4*)(gn + cw + bj * HALF + 4 * n);
#pragma unroll
        for (int ai = 0; ai < 2; ++ai)
#pragma unroll
            for (int mp = 0; mp < 2; ++mp) {
                u32x4 xo[2][2];
#pragma unroll
                for (int mm = 0; mm < 2; ++mm)
#pragma unroll
                    for (int bj = 0; bj < 2; ++bj) xo[mm][bj] = *(const u32x4*)(V + (size_t)(row0 + ai * HALF + (2 * mp + mm) * 16) * 1024 + col0 + bj * HALF);
#pragma unroll
                for (int mm = 0; mm < 2; ++mm) { const int m = 2 * mp + mm; const size_t row = (size_t)(row0 + ai * HALF + m * 16); const float h = hr[ai][m], s = rs[ai][m];
#pragma unroll
                    for (int bj = 0; bj < 2; ++bj) { const u32x4 x = xo[mm][bj]; const f32x4 r0 = acc[ai][bj][m][0] * s, r1 = acc[ai][bj][m][1] * s, g0 = gv[bj][0] * h, g1 = gv[bj][1] * h;
                        u32x4 w;
                        w.x = cvt_pk_bf16(bf_lo(x.x) * g0[0] * (r0[0] * fsigmoid(r0[0])), bf_hi(x.x) * g0[1] * (r0[1] * fsigmoid(r0[1])));
                        w.y = cvt_pk_bf16(bf_lo(x.y) * g0[2] * (r0[2] * fsigmoid(r0[2])), bf_hi(x.y) * g0[3] * (r0[3] * fsigmoid(r0[3])));
                        w.z = cvt_pk_bf16(bf_lo(x.z) * g1[0] * (r1[0] * fsigmoid(r1[0])), bf_hi(x.z) * g1[1] * (r1[1] * fsigmoid(r1[1])));
                        w.w = cvt_pk_bf16(bf_lo(x.w) * g1[2] * (r1[2] * fsigmoid(r1[2])), bf_hi(x.w) * g1[3] * (r1[3] * fsigmoid(r1[3])));
                        *(u32x4*)(V + row * 1024 + col0 + bj * HALF) = w; } }
                asm volatile("" ::: "memory"); }
    }
};
struct EpiX {
    static constexpr bool PERM = true, AFTER_DRAIN = false;
    EpiO o; EpiGate g0; EpiGate g1;
    __device__ __forceinline__ void operator()(const f32x4 (&acc)[2][2][4][2], const Unit& u, int wr, int wc, int fr, int fq) const {
        if (u.st == 0) o(acc, u, wr, wc, fr, fq); else if (u.st == 1) g0(acc, u, wr, wc, fr, fq); else g1(acc, u, wr, wc, fr, fq);
    }
};
struct EpiY {
    static constexpr bool PERM = true, AFTER_DRAIN = false;
    EpiMix<0> m0; EpiMix<1> m1;
    __device__ __forceinline__ void operator()(const f32x4 (&acc)[2][2][4][2], const Unit& u, int wr, int wc, int fr, int fq) const {
        if (u.st == 0) m0(acc, u, wr, wc, fr, fq); else m1(acc, u, wr, wc, fr, fq);
    }
};

template <class Epi, class Sched, bool ALIGN_EPI = false, bool SP2 = false, class GemmT = Gemm>
__device__ __forceinline__ void gemm_phase(PG8_LAS unsigned char* lds, const GemmT g, const Sched& S, const Epi& E) {
    int tid_ = threadIdx.x; asm volatile("" : "+v"(tid_));
    const int tid = tid_, wid = __builtin_amdgcn_readfirstlane(tid >> 6), lane = tid & 63, wr = wid >> 2, wc = wid & 3, fr = lane & 15, fq = lane >> 4;
    const int K = g.K, nt = K / BK;
    unsigned voffA[2], voffB[2];
#pragma unroll
    for (int i = 0; i < 2; ++i) { int R, C; stage_rc(tid * 16 + i * 8192, R, C); const int Rb = Epi::PERM ? ((R & ~31) + perm32(R & 31)) : R;
        voffA[i] = (unsigned)(R * K + C) * 2u; voffB[i] = (unsigned)(Rb * K + C) * 2u; }
    const size_t kstep = (size_t)(BK * 2);
    const size_t hstep = (size_t)HALF * K * 2;
    const size_t tstep = 2 * hstep;
    const unsigned ldsw = (unsigned)wid * 1024u;
    const int aoff = lds_byte(wr * 64 + fr, fq * 8), boff = lds_byte(wc * 32 + fr, fq * 8);
#define PG8_SA(b, h) (((b) * 2 + (h)) * HTB)
#define PG8_SB(b, h) ((4 + (b) * 2 + (h)) * HTB)
#define PG8_STAGE(bufoff, gbase, voff) do { _Pragma("unroll") for (int _i = 0; _i < 2; ++_i) \
        __builtin_amdgcn_global_load_lds((const unsigned*)((const char*)(gbase) + (voff)[_i]), (PG8_LAS unsigned*)(lds + (bufoff) + ldsw + _i * 8192), 16, 0, 0); } while (0)
#define PG8_LDA(dst, b, h) do { _Pragma("unroll") for (int m = 0; m < 4; ++m) _Pragma("unroll") for (int k = 0; k < 2; ++k) dst[m][k] = *(const PG8_LAS bf16x8*)(lds + PG8_SA(b, h) + aoff + m * 2048 + k * 1024); } while (0)
#define PG8_LDB(dst, b, h) do { _Pragma("unroll") for (int n = 0; n < 2; ++n) _Pragma("unroll") for (int k = 0; k < 2; ++k) dst[n][k] = *(const PG8_LAS bf16x8*)(lds + PG8_SB(b, h) + boff + n * 2048 + k * 1024); } while (0)
#define PG8_MMA(ai, bj, At, Bt) do { __builtin_amdgcn_s_setprio(1); _Pragma("unroll") for (int m = 0; m < 4; ++m) _Pragma("unroll") for (int n = 0; n < 2; ++n) _Pragma("unroll") for (int k = 0; k < 2; ++k) \
        acc[ai][bj][m][n] = __builtin_amdgcn_mfma_f32_16x16x32_bf16(Bt[n][k], At[m][k], acc[ai][bj][m][n], 0, 0, 0); __builtin_amdgcn_s_setprio(0); } while (0)
#define PG8_WAIT_V(n) asm volatile("s_waitcnt vmcnt(" #n ")" ::: "memory")
#define PG8_WAIT_L(n) asm volatile("s_waitcnt lgkmcnt(" #n ")" ::: "memory")
#define PG8_BAR __builtin_amdgcn_s_barrier()
#define PG8_SCHED __builtin_amdgcn_sched_barrier(0)
    Unit cur, nxt; int ui = 0;
    if (!S.next(0, cur)) return;
    f32x4 acc[2][2][4][2];
#pragma unroll
    for (int a = 0; a < 2; ++a)
#pragma unroll
        for (int b = 0; b < 2; ++b)
#pragma unroll
            for (int m = 0; m < 4; ++m)
#pragma unroll
                for (int n = 0; n < 2; ++n) acc[a][b][m][n] = (f32x4){0.f, 0.f, 0.f, 0.f};
    bf16x8 At[4][2], B0[2][2], B1[2][2];
    const char* cA = (const char*)g.a_of(cur) + (size_t)cur.pm * tstep; const char* cB = (const char*)g.b_of(cur) + (size_t)cur.pn * tstep;
    S.a_ready(cur);
    if constexpr (SP2) {
        PG8_STAGE(PG8_SB(0, 0), cB, voffB); PG8_STAGE(PG8_SB(0, 1), cB + hstep, voffB); PG8_STAGE(PG8_SA(0, 0), cA, voffA); PG8_STAGE(PG8_SA(0, 1), cA + hstep, voffA);
        if (wr == 1) PG8_BAR;
        PG8_WAIT_V(2); PG8_BAR;
        PG8_STAGE(PG8_SB(1, 0), cB + kstep, voffB); PG8_STAGE(PG8_SA(1, 0), cA + kstep, voffA); PG8_STAGE(PG8_SB(1, 1), cB + hstep + kstep, voffB);
        PG8_WAIT_V(6); PG8_BAR;
    } else {
        PG8_STAGE(PG8_SB(0, 0), cB, voffB); PG8_STAGE(PG8_SA(0, 0), cA, voffA); PG8_STAGE(PG8_SB(0, 1), cB + hstep, voffB); PG8_STAGE(PG8_SA(0, 1), cA + hstep, voffA);
        if (wr == 1) PG8_BAR;
        PG8_WAIT_V(4); PG8_BAR;
        PG8_STAGE(PG8_SB(1, 0), cB + kstep, voffB); PG8_STAGE(PG8_SA(1, 0), cA + kstep, voffA); PG8_STAGE(PG8_SB(1, 1), cB + hstep + kstep, voffB);
        PG8_WAIT_V(6); PG8_BAR;
    }
    for (;;) {
        const bool has_next = S.next(ui + 1, nxt);
        const char* nA = has_next ? (const char*)g.a_of(nxt) + (size_t)nxt.pm * tstep : cA; const char* nB = has_next ? (const char*)g.b_of(nxt) + (size_t)nxt.pn * tstep : cB;
        for (int t = 0; t < nt; t += 2) {
            const bool last = (t == nt - 2);
            const char* a1 = cA + (size_t)(t + 1) * kstep;
            const char* a2 = last ? nA : cA + (size_t)(t + 2) * kstep; const char* b2 = last ? nB : cB + (size_t)(t + 2) * kstep;
            const char* a3 = a2 + kstep; const char* b3 = b2 + kstep;
            if (last && has_next) S.a_ready(nxt);
            if constexpr (SP2) {
            PG8_LDB(B0, 0, 0); PG8_LDB(B1, 0, 1); PG8_SCHED; PG8_LDA(At, 0, 0); PG8_STAGE(PG8_SA(1, 1), a1 + hstep, voffA);
            PG8_WAIT_V(8); PG8_WAIT_L(0); PG8_BAR; PG8_MMA(0, 0, At, B0); PG8_MMA(0, 1, At, B1); PG8_BAR; PG8_SCHED;
            PG8_LDA(At, 0, 1); PG8_STAGE(PG8_SB(0, 0), b2, voffB); PG8_STAGE(PG8_SB(0, 1), b2 + hstep, voffB); PG8_STAGE(PG8_SA(0, 0), a2, voffA);
            PG8_WAIT_V(8); PG8_WAIT_L(0); PG8_BAR; PG8_MMA(1, 0, At, B0); PG8_MMA(1, 1, At, B1); PG8_BAR; PG8_SCHED;
            PG8_LDB(B0, 1, 0); PG8_LDB(B1, 1, 1); PG8_SCHED; PG8_LDA(At, 1, 0); PG8_STAGE(PG8_SA(0, 1), a2 + hstep, voffA);
            PG8_WAIT_V(8); PG8_WAIT_L(0); PG8_BAR; PG8_MMA(0, 0, At, B0); PG8_MMA(0, 1, At, B1); PG8_BAR; PG8_SCHED;
            PG8_LDA(At, 1, 1); PG8_STAGE(PG8_SB(1, 0), b3, voffB); PG8_STAGE(PG8_SB(1, 1), b3 + hstep, voffB); PG8_STAGE(PG8_SA(1, 0), a3, voffA);
            PG8_WAIT_V(8); PG8_WAIT_L(0); PG8_BAR; PG8_MMA(1, 0, At, B0); PG8_MMA(1, 1, At, B1); PG8_BAR; PG8_SCHED;
            } else {
            PG8_LDB(B0, 0, 0); PG8_SCHED; PG8_LDA(At, 0, 0); PG8_STAGE(PG8_SA(1, 1), a1 + hstep, voffA);
            PG8_WAIT_L(8); PG8_BAR; PG8_WAIT_L(0); PG8_MMA(0, 0, At, B0); PG8_BAR; PG8_SCHED;
            PG8_LDB(B1, 0, 1); PG8_STAGE(PG8_SB(0, 0), b2, voffB);
            PG8_BAR; PG8_WAIT_L(0); PG8_MMA(0, 1, At, B1); PG8_BAR;
            PG8_LDA(At, 0, 1); PG8_STAGE(PG8_SA(0, 0), a2, voffA);
            PG8_BAR; PG8_WAIT_L(0); PG8_MMA(1, 0, At, B0); PG8_BAR; PG8_SCHED;
            PG8_STAGE(PG8_SB(0, 1), b2 + hstep, voffB);
            PG8_WAIT_V(6); PG8_BAR; PG8_MMA(1, 1, At, B1); PG8_BAR;
            PG8_LDB(B0, 1, 0); PG8_SCHED; PG8_LDA(At, 1, 0); PG8_STAGE(PG8_SA(0, 1), a2 + hstep, voffA);
            PG8_WAIT_L(8); PG8_BAR; PG8_WAIT_L(0); PG8_MMA(0, 0, At, B0); PG8_BAR; PG8_SCHED;
            PG8_LDB(B1, 1, 1); PG8_STAGE(PG8_SB(1, 0), b3, voffB);
            PG8_BAR; PG8_WAIT_L(0); PG8_MMA(0, 1, At, B1); PG8_BAR;
            PG8_LDA(At, 1, 1); PG8_STAGE(PG8_SA(1, 0), a3, voffA);
            PG8_BAR; PG8_WAIT_L(0); PG8_MMA(1, 0, At, B0); PG8_BAR; PG8_SCHED;
            PG8_STAGE(PG8_SB(1, 1), b3 + hstep, voffB);
            PG8_WAIT_V(6); PG8_BAR; PG8_MMA(1, 1, At, B1); PG8_BAR;
            }
        }
        if constexpr (ALIGN_EPI) { if (wr == 0) PG8_BAR; }
        if constexpr (!Epi::AFTER_DRAIN) { E(acc, cur, wr, wc, fr, fq); S.done(cur); }
        if (!has_next) break;
#pragma unroll
        for (int a = 0; a < 2; ++a)
#pragma unroll
            for (int b = 0; b < 2; ++b)
#pragma unroll
                for (int m = 0; m < 4; ++m)
#pragma unroll
                    for (int n = 0; n < 2; ++n) acc[a][b][m][n] = (f32x4){0.f, 0.f, 0.f, 0.f};
        cur = nxt; cA = nA; cB = nB; ++ui;
        if constexpr (ALIGN_EPI) { if (wr == 1) PG8_BAR; }
    }
    PG8_WAIT_V(0);
    if constexpr (!ALIGN_EPI) { if (wr == 0) PG8_BAR; }
    PG8_BAR;
    if constexpr (Epi::AFTER_DRAIN) { E.fused(acc, cur, wr, wc, fr, fq, lds, wid, lane); S.done(cur); }
#undef PG8_SA
#undef PG8_SB
#undef PG8_STAGE
#undef PG8_LDA
#undef PG8_LDB
#undef PG8_MMA
#undef PG8_WAIT_V
#undef PG8_WAIT_L
#undef PG8_BAR
#undef PG8_SCHED
}
}

#define LAS __attribute__((address_space(3)))
typedef unsigned short bf16;
typedef float f32x4 __attribute__((ext_vector_type(4)));
typedef short bf16x8 __attribute__((ext_vector_type(8)));
typedef unsigned v4u __attribute__((ext_vector_type(4)));
typedef unsigned v2u __attribute__((ext_vector_type(2)));

constexpr int M = 32768, D = 1024, SEQ = 4096, NIN = 8208, NIN1 = 6400, FF = 2816, NGU = 5632;
constexpr size_t MiB = 1u << 20;
constexpr size_t WS_W0 = 1 * MiB, WS_WL = 40 * MiB;
constexpr size_t WO_IN = 0, WO_OA = 17 * MiB, WO_OB = 19 * MiB, WO_O = 21 * MiB, WO_GU = 23 * MiB, WO_D = 34 * MiB;
constexpr size_t WS_SSQ = 81 * MiB, WS_GSSQ = 83 * MiB, WS_FZ = 91 * MiB, WS_XB = 96 * MiB, WS_Q = 160 * MiB, WS_K = 192 * MiB, WS_V = 224 * MiB,
                 WS_R = 288 * MiB, WS_U = 352 * MiB, WS_GBIN = 416 * MiB, WS_KDT = 480 * MiB, WS_END = 512 * MiB;
constexpr size_t WS_GAM = 93 * MiB;
constexpr size_t WS_GA = WS_Q, WS_GB = WS_R, WS_HID = WS_Q;
constexpr int LDS_BYTES = 147456;

#define LDS_WAIT() asm volatile("s_waitcnt lgkmcnt(0)" ::: "memory")
__device__ __forceinline__ unsigned f2bf(float f) { unsigned u = __builtin_bit_cast(unsigned, f); return (u + 0x7fffu + ((u >> 16) & 1u)) >> 16; }
__device__ __forceinline__ unsigned pk2(float lo, float hi) { return pg8::cvt_pk_bf16(lo, hi); }
__device__ __forceinline__ float wave_sum(float v) {
#pragma unroll
    for (int o = 1; o < 64; o <<= 1) v += __shfl_xor(v, o);
    return v;
}
__device__ __forceinline__ float bflo(unsigned w) { return __uint_as_float(w << 16); }
__device__ __forceinline__ float bfhi(unsigned w) { return __uint_as_float(w & 0xffff0000u); }
__device__ __forceinline__ void load16(const bf16* p, float (&f)[16]) {
    const v4u a = *(const v4u*)p, b = *(const v4u*)(p + 8);
    f[0] = bflo(a.x); f[1] = bfhi(a.x); f[2] = bflo(a.y); f[3] = bfhi(a.y); f[4] = bflo(a.z); f[5] = bfhi(a.z); f[6] = bflo(a.w); f[7] = bfhi(a.w);
    f[8] = bflo(b.x); f[9] = bfhi(b.x); f[10] = bflo(b.y); f[11] = bfhi(b.y); f[12] = bflo(b.z); f[13] = bfhi(b.z); f[14] = bflo(b.w); f[15] = bfhi(b.w);
}
__device__ __forceinline__ void store16(bf16* p, const float (&f)[16]) {
    v4u a, b; a.x = pk2(f[0], f[1]); a.y = pk2(f[2], f[3]); a.z = pk2(f[4], f[5]); a.w = pk2(f[6], f[7]);
    b.x = pk2(f[8], f[9]); b.y = pk2(f[10], f[11]); b.z = pk2(f[12], f[13]); b.w = pk2(f[14], f[15]);
    *(v4u*)p = a; *(v4u*)(p + 8) = b;
}

__device__ __forceinline__ void load8(const bf16* p, float (&f)[8]) {
    const v4u a = *(const v4u*)p;
    f[0] = bflo(a.x); f[1] = bfhi(a.x); f[2] = bflo(a.y); f[3] = bfhi(a.y); f[4] = bflo(a.z); f[5] = bfhi(a.z); f[6] = bflo(a.w); f[7] = bfhi(a.w);
}
__device__ __forceinline__ void store8(bf16* p, const float (&f)[8]) {
    v4u a; a.x = pk2(f[0], f[1]); a.y = pk2(f[2], f[3]); a.z = pk2(f[4], f[5]); a.w = pk2(f[6], f[7]); *(v4u*)p = a;
}

template <bool GAIN> __device__ __forceinline__ void tr_item_(const float* W, int Nsrc, int col, const float* gain, bf16* WT, int K, int drow0, int k0, LAS float* scr, int lane) {
    const int colc = col >= 0 ? col : 0; const float msk = col >= 0 ? 1.f : 0.f;
    float vv[32];
#pragma unroll
    for (int i = 0; i < 32; ++i) { const int kk = 2 * i + (lane >> 5); vv[i] = W[(size_t)(k0 + kk) * Nsrc + colc]; }
    if (GAIN) {
        float gg[32];
#pragma unroll
        for (int i = 0; i < 32; ++i) gg[i] = gain[k0 + 2 * i + (lane >> 5)];
#pragma unroll
        for (int i = 0; i < 32; ++i) vv[i] *= gg[i];
    }
#pragma unroll
    for (int i = 0; i < 32; ++i) { const int kk = 2 * i + (lane >> 5); scr[kk * 33 + (lane & 31)] = vv[i] * msk; }
    LDS_WAIT(); asm volatile("" ::: "memory");
    const int c = lane & 7;
#pragma unroll
    for (int j = 0; j < 4; ++j) { const int n = (lane >> 3) + 8 * j; const LAS float* s = scr + (8 * c) * 33 + n;
        v4u o; o.x = pk2(s[0 * 33], s[1 * 33]); o.y = pk2(s[2 * 33], s[3 * 33]); o.z = pk2(s[4 * 33], s[5 * 33]); o.w = pk2(s[6 * 33], s[7 * 33]);
        *(v4u*)(WT + (size_t)(drow0 + n) * K + k0 + 8 * c) = o; }
    LDS_WAIT(); asm volatile("" ::: "memory");
}
__device__ __forceinline__ void tr_item(const float* W, int Nsrc, int col, const float* gain, bf16* WT, int K, int drow0, int k0, LAS float* scr, int lane) {
    if (gain) tr_item_<true>(W, Nsrc, col, gain, WT, K, drow0, k0, scr, lane); else tr_item_<false>(W, Nsrc, col, gain, WT, K, drow0, k0, scr, lane);
}
__device__ __forceinline__ int in_src_col(int d) {
    if (d < 3072) return d;
    if (d < 5120) { const int j = (d - 3072) >> 8, i = (d - 3072) & 255; return i < 128 ? 4112 + 128 * j + i : 5136 + 128 * j + (i - 128); }
    if (d < 6144) return 3088 + (d - 5120);
    if (d < 6400) { const int i = d - 6144; return i < 16 ? 3072 + i : -1; }
    return 6160 + (d - 6400);
}

struct Args { const float* in[16]; float* out; unsigned char* ws; };

#define RLX_AGENT __ATOMIC_RELAXED, __HIP_MEMORY_SCOPE_AGENT
#define XB_TMO      128
#define XB_XCNT(j)  (256  + 64 * (j))
#define XB_XSUB(j)  (1280 + 64 * (j))
#define XB_XGEN(j)  (2304 + 64 * (j))
#define XB_TOP      3328
#define XB_TOPGEN   3392
#define XCD_BAR_WORDS 3456
#define XB_SPIN_CAP (1u << 18)

__device__ __forceinline__ unsigned xb_ld(unsigned* p)              { return __hip_atomic_load(p, __ATOMIC_RELAXED, __HIP_MEMORY_SCOPE_AGENT); }
__device__ __forceinline__ unsigned xb_add(unsigned* p, unsigned v) { return __hip_atomic_fetch_add(p, v, __ATOMIC_RELAXED, __HIP_MEMORY_SCOPE_AGENT); }
__device__ __forceinline__ unsigned xb_xcc_id() { return (unsigned)__builtin_amdgcn_s_getreg((3 << 11) | 20) & 0xFu; }
#define XB_SPIN(cond, bar) do { unsigned _sp = 0; while (cond) { __builtin_amdgcn_s_sleep(1); \
    if ((++_sp & 255u) == 0u) { if (xb_ld(&(bar)[XB_TMO])) break; if (_sp > XB_SPIN_CAP) { atomicAdd(&(bar)[XB_TMO], 1u); break; } } } } while (0)

struct XcdBarrier {
    unsigned* bar; unsigned x;
    volatile LAS unsigned* st;
};

__device__ __forceinline__ XcdBarrier xcd_barrier_post(unsigned* bar, volatile LAS unsigned* st) {
    XcdBarrier b; b.bar = bar; b.x = xb_xcc_id(); b.st = st;
    if (threadIdx.x == 0) (void)xb_add(&bar[XB_XCNT(b.x)], 1u);
    return b;
}
__device__ __forceinline__ void xcd_barrier_complete(unsigned* bar, unsigned x, unsigned& nloc, unsigned& nx) {
    const unsigned G = gridDim.x * gridDim.y * gridDim.z;
    unsigned sum, cnt, mine, sp = 0u;
    for (;;) {
        sum = 0u; cnt = 0u; mine = 0u;
#pragma unroll
        for (unsigned j = 0; j < 16; ++j) { const unsigned c = xb_ld(&bar[XB_XCNT(j)]); sum += c; cnt += (c > 0u) ? 1u : 0u; mine = (j == x) ? c : mine; }
        if (sum == G) break;
        __builtin_amdgcn_s_sleep(1);
        if ((++sp & 255u) == 0u) { if (xb_ld(&bar[XB_TMO])) break; if (sp > XB_SPIN_CAP) { atomicAdd(&bar[XB_TMO], 1u); break; } }
    }
    nloc = mine > 0u ? mine : 1u; nx = cnt > 0u ? cnt : 1u;
}

__device__ __forceinline__ void xcd_barrier(const XcdBarrier& b) {
    asm volatile("s_waitcnt vmcnt(0)" ::: "memory");
    __syncthreads();
    if (threadIdx.x == 0) {
        unsigned* bar = b.bar;
        __builtin_amdgcn_s_waitcnt(0);
        unsigned nloc = b.st[0], nx = b.st[1];
        if (nloc == 0u) { xcd_barrier_complete(bar, b.x, nloc, nx); b.st[0] = nloc; b.st[1] = nx; }
        const unsigned old = xb_add(&bar[XB_XSUB(b.x)], 1u);
        const unsigned gen = old / nloc;
        if (old + 1u == (gen + 1u) * nloc) {
            __builtin_amdgcn_fence(__ATOMIC_RELEASE, "agent");
            asm volatile("s_waitcnt vmcnt(0)" ::: "memory");
            const unsigned og = xb_add(&bar[XB_TOP], 1u);
            const unsigned tg = og / nx;
            if (og + 1u == (tg + 1u) * nx) xb_add(&bar[XB_TOPGEN], 1u);
            else XB_SPIN(xb_ld(&bar[XB_TOPGEN]) == tg, bar);
            __builtin_amdgcn_fence(__ATOMIC_ACQUIRE, "agent");
            xb_add(&bar[XB_XGEN(b.x)], 1u);
            asm volatile("s_waitcnt vmcnt(0)" ::: "memory");
        } else {
            XB_SPIN(xb_ld(&bar[XB_XGEN(b.x)]) == gen, bar);
            __builtin_amdgcn_fence(__ATOMIC_ACQUIRE, "agent");
            asm volatile("s_waitcnt vmcnt(0)" ::: "memory");
        }
    }
    __syncthreads();
}

template <int OFF> __device__ __forceinline__ const void* karg_ptr() {
    unsigned long long v; auto k = __builtin_amdgcn_kernarg_segment_ptr();
    asm volatile("s_load_dwordx2 %0, %1, %2\n\ts_waitcnt lgkmcnt(0)" : "=s"(v) : "s"(k), "n"(OFF) : "memory");
    return (const void*)(const __attribute__((address_space(1))) void*)v; }
#define IN_PTR(i) ((const float*)karg_ptr<8 * (i)>())
#define OUT_PTR() ((float*)karg_ptr<128>())
#define WS_PTR() ((unsigned char*)karg_ptr<136>())

__device__ __forceinline__ int otid() { int t = threadIdx.x; asm volatile("" : "+v"(t)); return t; }
__device__ __forceinline__ int obx() { int t = blockIdx.x; asm volatile("" : "+s"(t)); return t; }
__device__ __forceinline__ int ogdim() { int t = gridDim.x; asm volatile("" : "+s"(t)); return t; }

#define LDS_BAR() do { asm volatile("s_waitcnt lgkmcnt(0)" ::: "memory"); __builtin_amdgcn_s_barrier(); asm volatile("" ::: "memory"); } while (0)
__device__ __forceinline__ void gla_pre_item(LAS unsigned char* lds, int item, const bf16* XB, const bf16* Wfz, const float* SSQ, const bf16* Kb, const float* wfg2, const float* bfg, bf16* KDT, float* GAM) {
    const int tid = otid(), lane = tid & 63, w = __builtin_amdgcn_readfirstlane(tid >> 6), l15 = lane & 15, lq = lane >> 4;
    const int b = item >> 6, c = item & 63;
    const size_t row0 = (size_t)b * SEQ + (size_t)c * 64;
    LAS float* fzs = (LAS float*)lds;
    LAS float* tot = (LAS float*)(lds + 4096);
    LAS f32x4* part = (LAS f32x4*)(lds + 8192);
    LAS float* rsd = (LAS float*)(lds + 12288);
    LAS unsigned char* img = lds + 16384;
    const int kcol = tid & 127, tg = tid >> 7;
    { const float* sp = SSQ + (row0 + (tid >> 3)) * 16 + (tid & 7) * 2; float v = sp[0] + sp[1];
      v += __shfl_xor(v, 1); v += __shfl_xor(v, 2); v += __shfl_xor(v, 4);
      if ((tid & 7) == 0) rsd[tid >> 3] = __builtin_amdgcn_rsqf(v * (1.0f / 1024.0f) + 1e-6f); }
    float wfn[16]; float bfn; unsigned short kn[16];
#define PRE_LOAD(hh) do { _Pragma("unroll") for (int r = 0; r < 16; ++r) wfn[r] = wfg2[r * 512 + (hh) * 128 + kcol]; bfn = bfg[(hh) * 128 + kcol]; \
        const bf16* kp_ = Kb + (row0 + tg * 16) * 512 + (hh) * 128 + kcol; _Pragma("unroll") for (int i = 0; i < 16; ++i) kn[i] = kp_[i * 512]; } while (0)
    PRE_LOAD(0);
    { const int mt = w & 3, kh = w >> 2; f32x4 acc = (f32x4){0.f, 0.f, 0.f, 0.f};
      const bf16* ap = XB + (row0 + 16 * mt + l15) * 1024 + 512 * kh + 8 * lq; const bf16* bp = Wfz + (size_t)l15 * 1024 + 512 * kh + 8 * lq;
#pragma unroll
      for (int ks = 0; ks < 16; ++ks) acc = __builtin_amdgcn_mfma_f32_16x16x32_bf16(*(const bf16x8*)(ap + 32 * ks), *(const bf16x8*)(bp + 32 * ks), acc, 0, 0, 0);
      if (kh == 1) part[mt * 64 + lane] = acc;
      LDS_BAR();
      if (kh == 0) { const f32x4 o = part[mt * 64 + lane] + acc;
#pragma unroll
          for (int r = 0; r < 4; ++r) { const int tok = 16 * mt + 4 * lq + r; fzs[tok * 16 + l15] = o[r] * rsd[tok]; } }
      LDS_BAR(); }
#pragma unroll 1
    for (int h = 0; h < 4; ++h) {
        const int it = ((b * 4 + h) << 6) + c;
        if (h > 0) { v4u* dstp = (v4u*)(KDT + (size_t)(it - 64) * 8192); const int p0 = tid, p1 = tid + 512;
            dstp[p0] = *(const LAS v4u*)(img + (p0 >> 3) * 144 + (p0 & 7) * 16); dstp[p1] = *(const LAS v4u*)(img + (p1 >> 3) * 144 + (p1 & 7) * 16); }
        float wf[16]; unsigned short kc[16];
#pragma unroll
        for (int r = 0; r < 16; ++r) { wf[r] = wfn[r]; kc[r] = kn[r]; }
        const float bf = bfn;
        { const int hn = (h < 3) ? h + 1 : 3; PRE_LOAD(hn); }
        float cum[16]; float run = 0.f;
#pragma unroll
        for (int i = 0; i < 16; ++i) { const LAS f32x4* z = (const LAS f32x4*)(fzs + (tg * 16 + i) * 16); float f = bf;
#pragma unroll
            for (int r4 = 0; r4 < 4; ++r4) { const f32x4 zz = z[r4]; f += zz.x * wf[4 * r4] + zz.y * wf[4 * r4 + 1] + zz.z * wf[4 * r4 + 2] + zz.w * wf[4 * r4 + 3]; }
            const float la = (fminf(f, 0.f) - __logf(1.0f + __expf(-fabsf(f)))) * (1.0f / 16.0f);
            run += la; cum[i] = run; }
        tot[tg * 128 + kcol] = run;
        LDS_BAR();
        float pre = 0.f, all = 0.f;
#pragma unroll
        for (int g = 0; g < 4; ++g) { const float tv = tot[g * 128 + kcol]; all += tv; if (g < tg) pre += tv; }
        unsigned pk[8];
#pragma unroll
        for (int i = 0; i < 8; ++i) { const float e0 = __expf(all - (pre + cum[2 * i])), e1 = __expf(all - (pre + cum[2 * i + 1]));
            pk[i] = pk2(__uint_as_float((unsigned)kc[2 * i] << 16) * e0, __uint_as_float((unsigned)kc[2 * i + 1] << 16) * e1); }
        { LAS v4u* dst = (LAS v4u*)(img + kcol * 144 + tg * 32); dst[0] = (v4u){pk[0], pk[1], pk[2], pk[3]}; dst[1] = (v4u){pk[4], pk[5], pk[6], pk[7]}; }
        if (tg == 0) GAM[(size_t)it * 128 + kcol] = __expf(all);
        LDS_BAR();
    }
    { v4u* dstp = (v4u*)(KDT + (size_t)(((b * 4 + 3) << 6) + c) * 8192); const int p0 = tid, p1 = tid + 512;
      dstp[p0] = *(const LAS v4u*)(img + (p0 >> 3) * 144 + (p0 & 7) * 16); dstp[p1] = *(const LAS v4u*)(img + (p1 >> 3) * 144 + (p1 & 7) * 16); }
    LDS_BAR();
#undef PRE_LOAD
}

__device__ __forceinline__ void gla_scan_item(LAS unsigned char* lds, int item, const bf16* Qb, const bf16* Vb, bf16* Ob, const bf16* KDT, const float* GAM, float* GSSQ) {
    const int tid = otid(), lane = tid & 63, w = __builtin_amdgcn_readfirstlane(tid >> 6);
    const int b = item >> 5, h = (item >> 3) & 3, vs = item & 7, bh = b * 4 + h;
    const size_t rb = (size_t)b * SEQ;
    LAS unsigned char* vt = lds;
    LAS unsigned char* st = lds + 4608;
    LAS unsigned char* kdt = lds + 13312;
    LAS unsigned char* qt = lds + 31744;
    f32x4 S0 = (f32x4){0.f, 0.f, 0.f, 0.f}, S1 = (f32x4){0.f, 0.f, 0.f, 0.f};
    const int mt = w >> 1, nt = w & 1, l15 = lane & 15, lq = lane >> 4;
    const int vtok = tid >> 3, vc4 = (tid & 7) * 4;
    const bf16* kdp = KDT + (size_t)bh * 64 * 8192 + (size_t)tid * 8;
    const bf16* qp = Qb + (rb + (tid >> 4)) * 512 + h * 128 + (tid & 15) * 8;
    const float* gp = GAM + (size_t)bh * 64 * 128 + 16 * w + 4 * lq;
    const bf16* vp = Vb + (rb + vtok) * 1024 + h * 256 + vs * 32 + vc4;
    const int kd_dst = (tid >> 3) * 144 + (tid & 7) * 16, q_dst = (tid >> 4) * 272 + (tid & 15) * 16;
    v4u KA[4][2], QA[4][2]; f32x4 G4[4]; v2u VN[4];
#define GLA_LOAD(j, c) do { KA[j][0] = *(const v4u*)(kdp + (size_t)(c) * 8192); KA[j][1] = *(const v4u*)(kdp + (size_t)(c) * 8192 + 4096); \
        QA[j][0] = *(const v4u*)(qp + (size_t)(c) * 64 * 512); QA[j][1] = *(const v4u*)(qp + (size_t)(c) * 64 * 512 + 32 * 512); \
        G4[j] = *(const f32x4*)(gp + (size_t)(c) * 128); VN[j] = *(const v2u*)(vp + (size_t)(c) * 64 * 1024); } while (0)
#pragma unroll
    for (int j = 0; j < 4; ++j) GLA_LOAD(j, j);
#pragma unroll 1
    for (int c0 = 0; c0 < 64; c0 += 4) {
#pragma unroll
        for (int j = 0; j < 4; ++j) {
            const int c = c0 + j; LAS unsigned char* qtc = qt + (j & 1) * 17408;
            { LAS unsigned short* vts = (LAS unsigned short*)vt; const v2u vc = VN[j];
              vts[(vc4 + 0) * 72 + vtok] = (unsigned short)(vc.x & 0xffffu); vts[(vc4 + 1) * 72 + vtok] = (unsigned short)(vc.x >> 16);
              vts[(vc4 + 2) * 72 + vtok] = (unsigned short)(vc.y & 0xffffu); vts[(vc4 + 3) * 72 + vtok] = (unsigned short)(vc.y >> 16);
              *(LAS v4u*)(kdt + kd_dst) = KA[j][0]; *(LAS v4u*)(kdt + kd_dst + 64 * 144) = KA[j][1];
              *(LAS v4u*)(qtc + q_dst) = QA[j][0]; *(LAS v4u*)(qtc + q_dst + 32 * 272) = QA[j][1]; }
            const f32x4 g4 = G4[j];
            { const int cn = (c + 4 < 64) ? c + 4 : 63; GLA_LOAD(j, cn); }
            LDS_BAR();
            { S0 = S0 * g4; S1 = S1 * g4;
#pragma unroll
              for (int ks = 0; ks < 2; ++ks) {
                  const bf16x8 a = *(const LAS bf16x8*)(kdt + (16 * w + l15) * 144 + (8 * lq + 32 * ks) * 2);
                  const bf16x8 b0 = *(const LAS bf16x8*)(vt + l15 * 144 + (8 * lq + 32 * ks) * 2);
                  const bf16x8 b1 = *(const LAS bf16x8*)(vt + (16 + l15) * 144 + (8 * lq + 32 * ks) * 2);
                  S0 = __builtin_amdgcn_mfma_f32_16x16x32_bf16(a, b0, S0, 0, 0, 0);
                  S1 = __builtin_amdgcn_mfma_f32_16x16x32_bf16(a, b1, S1, 0, 0, 0); }
              *(LAS v2u*)(st + l15 * 272 + (16 * w + 4 * lq) * 2) = (v2u){pk2(S0[0], S0[1]), pk2(S0[2], S0[3])};
              *(LAS v2u*)(st + (16 + l15) * 272 + (16 * w + 4 * lq) * 2) = (v2u){pk2(S1[0], S1[1]), pk2(S1[2], S1[3])}; }
            LDS_BAR();
            { f32x4 o = (f32x4){0.f, 0.f, 0.f, 0.f};
#pragma unroll
              for (int ks = 0; ks < 4; ++ks) { const bf16x8 sa = *(const LAS bf16x8*)(st + (16 * nt + l15) * 272 + (8 * lq + 32 * ks) * 2);
                  const bf16x8 qb = *(const LAS bf16x8*)(qtc + (16 * mt + l15) * 272 + (8 * lq + 32 * ks) * 2);
                  o = __builtin_amdgcn_mfma_f32_16x16x32_bf16(sa, qb, o, 0, 0, 0); }
              const size_t row = rb + (size_t)c * 64 + 16 * mt + l15;
              *(v2u*)(Ob + row * 1024 + h * 256 + vs * 32 + 16 * nt + 4 * lq) = (v2u){pk2(o[0], o[1]), pk2(o[2], o[3])};
              float ss = (o[0] * o[0] + o[1] * o[1]) + (o[2] * o[2] + o[3] * o[3]);
              ss += __shfl_xor(ss, 16); ss += __shfl_xor(ss, 32);
              GSSQ[(size_t)(h * 16 + vs * 2 + nt) * M + row] = ss; }
        }
    }
#undef GLA_LOAD
    __syncthreads();
}

__device__ __forceinline__ int fill_rstd(LAS unsigned char* lds, const float* ssq, const pg8::StaticOrder& S) {
    pg8::Unit u0; u0.pm = 0; u0.pn = 0; (void)S.next(0, u0);
    const int tid = otid(); LAS float* tab = (LAS float*)(lds + 131072 + 1024);
    float v[4];
#pragma unroll
    for (int s = 0; s < 4; ++s) { const int pm = (u0.pm + 8 * s < M / 256) ? u0.pm + 8 * s : M / 256 - 1;
        const f32x4* p = (const f32x4*)(ssq + ((size_t)pm * 256 + (tid >> 1)) * 16 + (tid & 1) * 8);
        const f32x4 a = p[0], b = p[1]; v[s] = ((a.x + a.y) + (a.z + a.w)) + ((b.x + b.y) + (b.z + b.w)); }
#pragma unroll
    for (int s = 0; s < 4; ++s) { float t = v[s]; t += __shfl_xor(t, 1);
        if ((tid & 1) == 0) tab[s * 256 + (tid >> 1)] = __builtin_amdgcn_rsqf(t * (1.0f / 1024.0f) + 1e-6f); }
    __syncthreads();
    return u0.pm;
}
#define RTAB(pm0) pg8::RTab{(const LAS float*)(lds + 131072 + 1024), (pm0)}

#ifndef RPT_P1
#define RPT_P1 1
#endif
#ifndef RPT_P4
#define RPT_P4 1
#endif
#ifndef RPT_P6
#define RPT_P6 1
#endif
#ifndef REPS
#define REPS 1
#endif
#define P4_FENCE() do { asm volatile("s_waitcnt vmcnt(0)" ::: "memory"); __builtin_amdgcn_fence(__ATOMIC_ACQUIRE, "agent"); asm volatile("s_waitcnt vmcnt(0)" ::: "memory"); __syncthreads(); } while (0)
#define WSP(T, off) ((T*)(WS_PTR() + (off)))
__global__ void __launch_bounds__(512, 2) fwd_mega(Args a) {
    extern __shared__ __attribute__((aligned(16))) unsigned char lds_raw[];
    cg::grid_group grid = cg::this_grid();
    LAS unsigned char* lds = (LAS unsigned char*)lds_raw;
#define TID (otid())
#define LANE (TID & 63)
#define WAVE (__builtin_amdgcn_readfirstlane(TID >> 6))
#define GDIM (ogdim())
#define BX (obx())
#define VCU ((GDIM % 8 == 0) ? (BX % 8) * (GDIM / 8) + BX / 8 : BX)
#define GW (VCU * 8 + WAVE)
#define NGW (GDIM * 8)

    for (int u = TID; u < (LDS_BYTES - 131072) / 4; u += 512) ((LAS unsigned*)(lds + 131072))[u] = 0u;
    __syncthreads();
    (void)xcd_barrier_post((unsigned*)(WS_PTR() + 16384), (volatile LAS unsigned*)(lds + 131072 + 352));
#define GRID_SYNC() do { XcdBarrier b_; b_.bar = (unsigned*)(WS_PTR() + 16384); b_.x = xb_xcc_id(); b_.st = (volatile LAS unsigned*)(lds + 131072 + 352); xcd_barrier(b_); } while (0)
#pragma unroll 1
    for (int rep = 0; rep < REPS; ++rep) {
#ifndef SKIP_P0
    {
        const int lane = LANE, gw = GW, ngw = NGW;
        unsigned char* ws = WS_PTR();
        LAS float* scr = (LAS float*)(lds + WAVE * 16384);
        constexpr int I_IN = 16 * 264, I_SQ = 512, I_GU = 16 * 176, I_D = 44 * 32, I_L = I_IN + 3 * I_SQ + I_GU + I_D;
        for (int it = gw; it < 2 * I_L; it += ngw) {
            const int l = it / I_L; int r = it % I_L; unsigned char* wb = ws + WS_W0 + (size_t)l * WS_WL;
            if (r < I_IN) { const int kb = r / 264, nb = r % 264; tr_item(IN_PTR(2) + (size_t)l * D * NIN, NIN, in_src_col(nb * 32 + (lane & 31)), IN_PTR(1) + l * D, (bf16*)(wb + WO_IN), D, nb * 32, kb * 64, scr, lane); continue; }
            r -= I_IN;
            if (r < 3 * I_SQ) { const int which = r / I_SQ, r2 = r % I_SQ, kb = r2 / 32, nb = r2 % 32; const float* src = (which == 0 ? IN_PTR(6) : which == 1 ? IN_PTR(9) : IN_PTR(10)) + (size_t)l * D * D;
                tr_item(src, D, nb * 32 + (lane & 31), nullptr, (bf16*)(wb + WO_OA + (size_t)which * 2 * MiB), D, nb * 32, kb * 64, scr, lane); continue; }
            r -= 3 * I_SQ;
            if (r < I_GU) { const int kb = r / 176, nb = r % 176, d0 = nb * 32, j = d0 >> 8, i = d0 & 255; const float* src = (i >= 128 ? IN_PTR(13) : IN_PTR(12)) + (size_t)l * D * FF;
                tr_item(src, FF, 128 * j + (i & 127) + (lane & 31), IN_PTR(11) + l * D, (bf16*)(wb + WO_GU), D, d0, kb * 64, scr, lane); continue; }
            r -= I_GU;
            { const int kb = r / 32, nb = r % 32; tr_item(IN_PTR(14) + (size_t)l * FF * D, D, nb * 32 + (lane & 31), nullptr, (bf16*)(wb + WO_D), FF, nb * 32, kb * 64, scr, lane); }
        }
        const float* x = IN_PTR(0); bf16* XB = (bf16*)(ws + WS_XB); float* SSQ = (float*)(ws + WS_SSQ);
        for (int m = 4 * gw; m < M; m += 4 * ngw) {
            f32x4 v[4][4]; float s[4];
#pragma unroll
            for (int r = 0; r < 4; ++r)
#pragma unroll
                for (int j = 0; j < 4; ++j) v[r][j] = ((const f32x4*)(x + (size_t)(m + r) * D) + lane)[64 * j];
#pragma unroll
            for (int r = 0; r < 4; ++r) { float t = 0.f;
#pragma unroll
                for (int j = 0; j < 4; ++j) t += (v[r][j].x * v[r][j].x + v[r][j].y * v[r][j].y) + (v[r][j].z * v[r][j].z + v[r][j].w * v[r][j].w);
                s[r] = wave_sum(t); }
#pragma unroll
            for (int r = 0; r < 4; ++r) { unsigned long long* o8 = (unsigned long long*)(XB + (size_t)(m + r) * D) + lane;
#pragma unroll
                for (int j = 0; j < 4; ++j) o8[64 * j] = (unsigned long long)pk2(v[r][j].x, v[r][j].y) | ((unsigned long long)pk2(v[r][j].z, v[r][j].w) << 32); }
            SSQ[(size_t)m * 16 + lane] = (lane == 0) ? s[0] : (lane == 16) ? s[1] : (lane == 32) ? s[2] : (lane == 48) ? s[3] : 0.f;
        }
    }
#endif
    asm volatile("s_waitcnt vmcnt(0)" ::: "memory"); grid.sync();
    GRID_SYNC();

#pragma unroll 1
    for (int l = 0; l < 2; ++l) {
#ifndef SKIP_P1
        for (int rp = 0; rp < RPT_P1; ++rp) { unsigned char* ws = WS_PTR();
          pg8::Gemm g{(const bf16*)(ws + WS_XB), (const bf16*)(ws + WS_W0 + (size_t)l * WS_WL + WO_IN), M, 5120, D}; pg8::P1Order S; S.init(M, 5120, GDIM, BX); const int pm0 = fill_rstd(lds, (const float*)(ws + WS_SSQ), S);
          pg8::EpiInProj E{(bf16*)(ws + WS_Q), (bf16*)(ws + WS_K), (bf16*)(ws + WS_V), (bf16*)(ws + WS_R), (bf16*)(ws + WS_U), (bf16*)(ws + WS_GBIN), (float*)(ws + WS_FZ), RTAB(pm0)};
          pg8::gemm_phase<pg8::EpiInProj, pg8::P1Order, true, true>(lds, g, S, E); }
#endif
        GRID_SYNC();
#ifndef SKIP_GLA
        { unsigned char* ws = WS_PTR();
          for (int item = VCU; item < 512; item += GDIM)
              gla_pre_item(lds, item, (const bf16*)(ws + WS_XB), (const bf16*)(ws + WS_W0 + (size_t)l * WS_WL + WO_IN) + (size_t)6144 * D, (const float*)(ws + WS_SSQ), (const bf16*)(ws + WS_K),
                           IN_PTR(3) + (size_t)l * 16 * 512, IN_PTR(4) + l * 512, (bf16*)(ws + WS_KDT), (float*)(ws + WS_GAM)); }
#endif
#ifndef SKIP_CONV
        {
            const int lane = LANE, gw = GW, ngw = NGW;
            unsigned char* ws = WS_PTR(); const bf16* Ub = (const bf16*)(ws + WS_U); bf16* GBIN = (bf16*)(ws + WS_GBIN);
            const float* cw = IN_PTR(7) + (size_t)l * 3 * D; const float* cb = IN_PTR(8) + l * D;
            for (int run = gw; run < M / 8; run += ngw) {
                const int m0 = (run >> 1) * 16, c0 = (run & 1) * 512 + lane * 8;
                float w0[8], w1[8], w2[8], bb[8], um2[8], um1[8];
#pragma unroll
                for (int j = 0; j < 8; ++j) { w0[j] = cw[c0 + j]; w1[j] = cw[D + c0 + j]; w2[j] = cw[2 * D + c0 + j]; bb[j] = cb[c0 + j]; }
                if ((m0 & (SEQ - 1)) == 0) {
#pragma unroll
                    for (int j = 0; j < 8; ++j) { um2[j] = 0.f; um1[j] = 0.f; }
                } else { load8(Ub + (size_t)(m0 - 2) * D + c0, um2); load8(Ub + (size_t)(m0 - 1) * D + c0, um1); }
#pragma unroll 1
                for (int i0 = 0; i0 < 16; i0 += 4) {
                    v4u ur[4], gr[4];
#pragma unroll
                    for (int r = 0; r < 4; ++r) { const size_t off = (size_t)(m0 + i0 + r) * D + c0; ur[r] = *(const v4u*)(Ub + off); gr[r] = *(const v4u*)(GBIN + off); }
#pragma unroll
                    for (int r = 0; r < 4; ++r) { const size_t off = (size_t)(m0 + i0 + r) * D + c0; float u0[8], gg[8], o[8];
                        u0[0] = bflo(ur[r].x); u0[1] = bfhi(ur[r].x); u0[2] = bflo(ur[r].y); u0[3] = bfhi(ur[r].y); u0[4] = bflo(ur[r].z); u0[5] = bfhi(ur[r].z); u0[6] = bflo(ur[r].w); u0[7] = bfhi(ur[r].w);
                        gg[0] = bflo(gr[r].x); gg[1] = bfhi(gr[r].x); gg[2] = bflo(gr[r].y); gg[3] = bfhi(gr[r].y); gg[4] = bflo(gr[r].z); gg[5] = bfhi(gr[r].z); gg[6] = bflo(gr[r].w); gg[7] = bfhi(gr[r].w);
#pragma unroll
                        for (int j = 0; j < 8; ++j) { o[j] = gg[j] * (w0[j] * um2[j] + w1[j] * um1[j] + w2[j] * u0[j] + bb[j]); um2[j] = um1[j]; um1[j] = u0[j]; }
                        store8(GBIN + off, o); }
                }
            }
        }
#endif
        GRID_SYNC();
#ifdef PROBE_SCAN
        { unsigned char* ws = WS_PTR();
          for (int item = VCU; item < 256; item += GDIM)
              gla_scan_item(lds, item, (const bf16*)(ws + WS_Q), (const bf16*)(ws + WS_V), (bf16*)(ws + WS_R), (const bf16*)(ws + WS_KDT), (const float*)(ws + WS_GAM), (float*)(ws + WS_GSSQ)); }
#endif
#ifndef SKIP_GLA
        { unsigned char* ws = WS_PTR();
          for (int item = VCU; item < 256; item += GDIM)
              gla_scan_item(lds, item, (const bf16*)(ws + WS_Q), (const bf16*)(ws + WS_V), (bf16*)(ws + WS_V), (const bf16*)(ws + WS_KDT), (const float*)(ws + WS_GAM), (float*)(ws + WS_GSSQ)); }
#endif
        GRID_SYNC();
#ifndef SKIP_P4
        { unsigned char* ws = WS_PTR(); const bf16* Win = (const bf16*)(ws + WS_W0 + (size_t)l * WS_WL + WO_IN); const bf16* XBp = (const bf16*)(ws + WS_XB);
          pg8::Gemm4 g{XBp, XBp, XBp, XBp, Win + (size_t)2048 * D, Win + (size_t)NIN1 * D, Win + (size_t)(NIN1 + D) * D, Win + (size_t)(NIN1 + D) * D, M, D, D};
          pg8::ChainOrder S; S.init(M, D, GDIM, BX); S.tpw = (M / 256) * (D / 256) / GDIM; S.ns = 3; const int pm0 = fill_rstd(lds, (const float*)(ws + WS_SSQ), S);
          if (S.tpw * GDIM == (M / 256) * (D / 256)) {
          pg8::EpiX E{pg8::EpiO{(bf16*)(ws + WS_V), (const float*)(ws + WS_GSSQ), IN_PTR(5) + l * 256, RTAB(pm0)}, pg8::EpiGate{(bf16*)(ws + WS_GA), RTAB(pm0)}, pg8::EpiGate{(bf16*)(ws + WS_GB), RTAB(pm0)}};
          pg8::gemm_phase<pg8::EpiX, pg8::ChainOrder, true, true, pg8::Gemm4>(lds, g, S, E); } }
#endif
        GRID_SYNC();
#ifndef SKIP_P4
        { unsigned char* ws = WS_PTR();
          const bf16* Ao = (const bf16*)(ws + WS_V); const bf16* Ac = (const bf16*)(ws + WS_GBIN); const bf16* Ba = (const bf16*)(ws + WS_W0 + (size_t)l * WS_WL + WO_OA); const bf16* Bb = (const bf16*)(ws + WS_W0 + (size_t)l * WS_WL + WO_OB);
          pg8::Gemm4 g{Ao, Ac, Ac, Ac, Ba, Bb, Bb, Bb, M, D, D};
          pg8::ChainOrder S; S.init(M, D, GDIM, BX); S.tpw = (M / 256) * (D / 256) / GDIM; S.ns = 2;
          if (S.tpw * GDIM == (M / 256) * (D / 256)) {
          pg8::EpiY E{pg8::EpiMix<0>{(const bf16*)(ws + WS_GA), (bf16*)(ws + WS_GA)}, pg8::EpiMix<1>{(const bf16*)(ws + WS_GB), (bf16*)(ws + WS_GA)}};
          pg8::gemm_phase<pg8::EpiY, pg8::ChainOrder, true, true, pg8::Gemm4>(lds, g, S, E); } }
#endif
        GRID_SYNC();
#ifndef SKIP_P5
        { unsigned char* ws = WS_PTR();
          pg8::Gemm g{(const bf16*)(ws + WS_GA), (const bf16*)(ws + WS_W0 + (size_t)l * WS_WL + WO_O), M, D, D}; pg8::StaticOrder S; S.init(M, D, GDIM, BX);
          pg8::EpiRes E{(bf16*)(ws + WS_XB), (float*)(ws + WS_SSQ)};
          pg8::gemm_phase<pg8::EpiRes, pg8::StaticOrder, true, true>(lds, g, S, E); }
#endif
        GRID_SYNC();
#ifndef SKIP_P6
        for (int rp = 0; rp < RPT_P6; ++rp) { unsigned char* ws = WS_PTR();
          pg8::Gemm g{(const bf16*)(ws + WS_XB), (const bf16*)(ws + WS_W0 + (size_t)l * WS_WL + WO_GU), M, NGU, D}; pg8::StaticOrder S; S.init(M, NGU, GDIM, BX); const int pm0 = fill_rstd(lds, (const float*)(ws + WS_SSQ), S);
          pg8::EpiFfn1 E{(bf16*)(ws + WS_HID), RTAB(pm0)};
          pg8::gemm_phase<pg8::EpiFfn1, pg8::StaticOrder, true, true>(lds, g, S, E); }
#endif
        GRID_SYNC();
#ifndef SKIP_P7
        { unsigned char* ws = WS_PTR();
          pg8::Gemm g{(const bf16*)(ws + WS_HID), (const bf16*)(ws + WS_W0 + (size_t)l * WS_WL + WO_D), M, D, FF}; pg8::StaticOrder S; S.init(M, D, GDIM, BX);
          pg8::EpiRes E{(bf16*)(ws + WS_XB), (float*)(ws + WS_SSQ)};
          pg8::gemm_phase<pg8::EpiRes, pg8::StaticOrder, true, true>(lds, g, S, E); }
#endif
        GRID_SYNC();
    }
    {
        const int lane = LANE, gw = GW, ngw = NGW;
        float* out = OUT_PTR(); const float* SSQ = (const float*)(WS_PTR() + WS_SSQ); const bf16* XB = (const bf16*)(WS_PTR() + WS_XB);
        float g[16];
#pragma unroll
        for (int j = 0; j < 16; ++j) g[j] = IN_PTR(15)[lane * 16 + j];
        for (int m = 4 * gw; m < M; m += 4 * ngw) {
            float s[4]; v4u xa[4], xb[4];
#pragma unroll
            for (int r = 0; r < 4; ++r) { s[r] = SSQ[(size_t)(m + r) * 16 + (lane & 15)]; xa[r] = *(const v4u*)(XB + (size_t)(m + r) * D + lane * 16); xb[r] = *(const v4u*)(XB + (size_t)(m + r) * D + lane * 16 + 8); }
#pragma unroll
            for (int r = 0; r < 4; ++r) { float t = (lane < 16) ? s[r] : 0.f; t = wave_sum(t);
                const float rstd = __builtin_amdgcn_rsqf(t * (1.0f / 1024.0f) + 1e-6f);
                float v[16];
                v[0] = bflo(xa[r].x); v[1] = bfhi(xa[r].x); v[2] = bflo(xa[r].y); v[3] = bfhi(xa[r].y); v[4] = bflo(xa[r].z); v[5] = bfhi(xa[r].z); v[6] = bflo(xa[r].w); v[7] = bfhi(xa[r].w);
                v[8] = bflo(xb[r].x); v[9] = bfhi(xb[r].x); v[10] = bflo(xb[r].y); v[11] = bfhi(xb[r].y); v[12] = bflo(xb[r].z); v[13] = bfhi(xb[r].z); v[14] = bflo(xb[r].w); v[15] = bfhi(xb[r].w);
                f32x4* o = (f32x4*)(out + (size_t)(m + r) * D + lane * 16);
#pragma unroll
                for (int j = 0; j < 4; ++j) o[j] = (f32x4){v[4 * j] * rstd * g[4 * j], v[4 * j + 1] * rstd * g[4 * j + 1], v[4 * j + 2] * rstd * g[4 * j + 2], v[4 * j + 3] * rstd * g[4 * j + 3]}; }
        }
    }
    GRID_SYNC();
    }
}

extern "C" void kernel_launch(void* const* d_in, const int* in_sizes, int n_in, void* d_out, int out_size, void* d_ws, size_t ws_size, hipStream_t stream) {
    static int grid = 0;
    if (grid == 0) {
        if (n_in != 16 || in_sizes[0] != M * D || out_size != M * D || ws_size < WS_END) { fprintf(stderr, "kernel_launch: unexpected shapes / workspace (n_in %d, ws %zu)\n", n_in, ws_size); grid = -1; return; }
        int dev = 0, cus = 0, per_cu = 0;
        if (hipGetDevice(&dev) != hipSuccess || hipDeviceGetAttribute(&cus, hipDeviceAttributeMultiprocessorCount, dev) != hipSuccess) { grid = -1; return; }
        if (hipFuncSetAttribute((const void*)fwd_mega, hipFuncAttributeMaxDynamicSharedMemorySize, LDS_BYTES) != hipSuccess) { fprintf(stderr, "kernel_launch: hipFuncSetAttribute failed\n"); grid = -1; return; }
        if (hipOccupancyMaxActiveBlocksPerMultiprocessor(&per_cu, (const void*)fwd_mega, 512, LDS_BYTES) != hipSuccess || per_cu < 1) { fprintf(stderr, "kernel_launch: occupancy query says %d blocks per CU\n", per_cu); per_cu = 1; }
        (void)hipGetLastError();
        grid = cus;
    }
    if (grid < 0) return;
    if (hipMemsetAsync(d_ws, 0, 1 << 20, stream) != hipSuccess) { fprintf(stderr, "kernel_launch: memset of the control words failed\n"); return; }
    Args a{};
    for (int i = 0; i < 16; ++i) a.in[i] = (const float*)d_in[i];
    a.out = (float*)d_out; a.ws = (unsigned char*)d_ws;
    void* args[] = {&a};
    hipError_t e = hipLaunchCooperativeKernel((const void*)fwd_mega, dim3(grid), dim3(512), args, LDS_BYTES, stream);
    if (e != hipSuccess) fprintf(stderr, "kernel_launch: cooperative launch failed: %s (grid %d)\n", hipGetErrorString(e), grid);
}
```

```cpp
#include <hip/hip_runtime.h>
#include <hip/hip_cooperative_groups.h>
#include <cstdio>
#include <cstdint>
namespace cg = cooperative_groups;
namespace pg8 {
#define PG8_LAS __attribute__((address_space(3)))
typedef unsigned short bf16_t;
typedef short bf16x8 __attribute__((ext_vector_type(8)));
typedef float f32x4 __attribute__((ext_vector_type(4)));
typedef unsigned u32x4 __attribute__((ext_vector_type(4)));
constexpr int BM = 256, BK = 64, HALF = 128, HTB = HALF * BK * 2  , STAGE_BYTES = 8 * HTB, NXCD = 8, WGM = 8;

__host__ __device__ __forceinline__ int lds_byte(int r, int c) { const int st = (r >> 4) * 2 + (c >> 5), rr = r & 15, cc = c & 31, ob = rr * 64 + cc * 2; return st * 1024 + (ob ^ (((ob >> 9) & 1) << 5)); }
__host__ __device__ __forceinline__ void stage_rc(int b, int& R, int& C) { const int st = b / 1024, sb = b % 1024, swz = sb ^ (((sb >> 9) & 1) << 5); R = (st >> 1) * 16 + swz / 64; C = (st & 1) * 32 + (swz % 64) / 2; }
__host__ __device__ __forceinline__ int perm32(int rho) { const int n = rho >> 4, i = rho & 15; return 8 * (i >> 2) + 4 * n + (i & 3); }

struct Unit { int pm, pn, st; };
struct Gemm { const bf16_t* A; const bf16_t* Bt; int M, N, K;
    __device__ __forceinline__ const bf16_t* a_of(const Unit&) const { return A; } __device__ __forceinline__ const bf16_t* b_of(const Unit&) const { return Bt; } };
struct Gemm4 { const bf16_t *A0, *A1, *A2, *A3, *B0, *B1, *B2, *B3; int M, N, K;
    __device__ __forceinline__ const bf16_t* a_of(const Unit& u) const { return u.st == 0 ? A0 : u.st == 1 ? A1 : u.st == 2 ? A2 : A3; }
    __device__ __forceinline__ const bf16_t* b_of(const Unit& u) const { return u.st == 0 ? B0 : u.st == 1 ? B1 : u.st == 2 ? B2 : B3; } };

struct StaticOrder {
    int nM, nN, nwg, G, c;
    __host__ __device__ void init(int M, int N, int G_, int c_) { nM = M / BM; nN = N / BM; nwg = nM * nN; G = G_; c = c_; }
    __host__ __device__ bool next(int i, Unit& u) const {
        const long L = (long)i * G + c; if (L >= nwg) return false;
        int wgid = (int)L; { const int q = nwg / NXCD, r = nwg % NXCD, xcd = wgid % NXCD, off = wgid / NXCD; wgid = (xcd < r ? xcd * (q + 1) : r * (q + 1) + (xcd - r) * q) + off; }
        const int nig = WGM * nN, gid = wgid / nig, fm = gid * WGM, gsz = (nM - fm) < WGM ? (nM - fm) : WGM;
        u.pm = fm + ((wgid % nig) % gsz); u.pn = (wgid % nig) / gsz; u.st = 0; return true;
    }
    __device__ __forceinline__ void a_ready(const Unit&) const {}
    __device__ __forceinline__ void done(const Unit&) const {}
};

struct ChainOrder : StaticOrder { int tpw, ns;
    __device__ bool next(int i, Unit& u) const { if (i >= ns * tpw) return false; const bool ok = StaticOrder::next(i / ns, u); u.st = i % ns; return ok; } };
struct P1Order : StaticOrder {
    __device__ bool next(int i, Unit& u) const { const bool ok = StaticOrder::next(i, u); if (u.pn >= 8) u.pn += 4; return ok; } };

typedef float f32x2_t __attribute__((ext_vector_type(2))); typedef __bf16 bf16x2_t __attribute__((ext_vector_type(2)));
__device__ __forceinline__ unsigned cvt_pk_bf16(float lo, float hi) { f32x2_t v = {lo, hi}; bf16x2_t b = __builtin_convertvector(v, bf16x2_t); return __builtin_bit_cast(unsigned, b); }
typedef float f32x2 __attribute__((ext_vector_type(2)));
typedef unsigned u32x2 __attribute__((ext_vector_type(2)));
__device__ __forceinline__ float bf_lo(unsigned w) { return __uint_as_float(w << 16); }
__device__ __forceinline__ float bf_hi(unsigned w) { return __uint_as_float(w & 0xffff0000u); }
__device__ __forceinline__ float fsigmoid(float x) { return __builtin_amdgcn_rcpf(1.0f + __expf(-x)); }
struct RTab { const PG8_LAS float* tab; int pm0; };
#define EPI_ROWS(rs, rt, u, wr, fr) float rs[2][4]; { const PG8_LAS float* rp_ = (rt).tab + (((u).pm - (rt).pm0) >> 3) * 256 + (wr) * 64 + (fr); \
    _Pragma("unroll") for (int ai = 0; ai < 2; ++ai) _Pragma("unroll") for (int m = 0; m < 4; ++m) rs[ai][m] = rp_[ai * HALF + m * 16]; }

struct EpiInProj {
    static constexpr bool PERM = true, AFTER_DRAIN = false;
    bf16_t *Q, *Kb, *V, *R, *U, *GBIN; float* FZ; RTab rt;
    __device__ __forceinline__ void operator()(const f32x4 (&acc)[2][2][4][2], const Unit& u, int wr, int wc, int fr, int fq) const {
        const int row0 = u.pm * BM + wr * 64 + fr, pn = u.pn;
        EPI_ROWS(rs, rt, u, wr, fr)
        if (pn >= 12 && pn < 20) {
            const int col0 = (pn - 12) * 128 + wc * 32 + 8 * fq;
#pragma unroll
            for (int ai = 0; ai < 2; ++ai)
#pragma unroll
                for (int m = 0; m < 4; ++m) { const float s = rs[ai][m] * rs[ai][m];
                    const f32x4 v0 = acc[ai][0][m][0] * acc[ai][1][m][0] * s, v1 = acc[ai][0][m][1] * acc[ai][1][m][1] * s;
                    u32x4 w; w.x = cvt_pk_bf16(v0[0], v0[1]); w.y = cvt_pk_bf16(v0[2], v0[3]); w.z = cvt_pk_bf16(v1[0], v1[1]); w.w = cvt_pk_bf16(v1[2], v1[3]);
                    *(u32x4*)(U + (size_t)(row0 + ai * HALF + m * 16) * 1024 + col0) = w; }
        } else if (pn == 24) {
            if (wc == 0 && fq < 2) {
#pragma unroll
                for (int ai = 0; ai < 2; ++ai)
#pragma unroll
                    for (int m = 0; m < 4; ++m) { float* p = FZ + (size_t)(row0 + ai * HALF + m * 16) * 16 + 8 * fq;
                        *(f32x4*)p = acc[ai][0][m][0] * rs[ai][m]; *(f32x4*)(p + 4) = acc[ai][0][m][1] * rs[ai][m]; }
            }
        } else {
            bf16_t* base; int ldc, colt; float sc = 1.0f;
            if (pn < 2) { base = Q; ldc = 512; colt = pn * 256; sc = 0.08838834764831845f; }
            else if (pn < 4) { base = Kb; ldc = 512; colt = (pn - 2) * 256; }
            else if (pn < 8) { base = V; ldc = 1024; colt = (pn - 4) * 256; }
            else if (pn < 12) { base = R; ldc = 1024; colt = (pn - 8) * 256; }
            else { base = GBIN; ldc = 1024; colt = (pn - 20) * 256; }
            const int col0 = colt + wc * 32 + 8 * fq;
#pragma unroll
            for (int ai = 0; ai < 2; ++ai)
#pragma unroll
                for (int m = 0; m < 4; ++m) { const float s = rs[ai][m] * sc; bf16_t* rowp = base + (size_t)(row0 + ai * HALF + m * 16) * ldc + col0;
#pragma unroll
                    for (int bj = 0; bj < 2; ++bj) { const f32x4 v0 = acc[ai][bj][m][0] * s, v1 = acc[ai][bj][m][1] * s;
                        u32x4 w; w.x = cvt_pk_bf16(v0[0], v0[1]); w.y = cvt_pk_bf16(v0[2], v0[3]); w.z = cvt_pk_bf16(v1[0], v1[1]); w.w = cvt_pk_bf16(v1[2], v1[3]);
                        *(u32x4*)(rowp + bj * HALF) = w; } }
        }
    }
};
struct EpiGate {
    static constexpr bool PERM = true, AFTER_DRAIN = false;
    bf16_t* G; RTab rt;
    __device__ __forceinline__ void operator()(const f32x4 (&acc)[2][2][4][2], const Unit& u, int wr, int wc, int fr, int fq) const {
        const int row0 = u.pm * BM + wr * 64 + fr, col0 = u.pn * BM + wc * 32 + 8 * fq;
        EPI_ROWS(rs, rt, u, wr, fr)
#pragma unroll
        for (int ai = 0; ai < 2; ++ai)
#pragma unroll
            for (int m = 0; m < 4; ++m) { const float s = rs[ai][m]; bf16_t* rowp = G + (size_t)(row0 + ai * HALF + m * 16) * 1024 + col0;
#pragma unroll
                for (int bj = 0; bj < 2; ++bj) { const f32x4 v0 = acc[ai][bj][m][0] * s, v1 = acc[ai][bj][m][1] * s;
                    u32x4 w; w.x = cvt_pk_bf16(fsigmoid(v0[0]), fsigmoid(v0[1])); w.y = cvt_pk_bf16(fsigmoid(v0[2]), fsigmoid(v0[3]));
                    w.z = cvt_pk_bf16(fsigmoid(v1[0]), fsigmoid(v1[1])); w.w = cvt_pk_bf16(fsigmoid(v1[2]), fsigmoid(v1[3]));
                    *(u32x4*)(rowp + bj * HALF) = w; } }
    }
};
template <int ADD> struct EpiMix {
    static constexpr bool PERM = true, AFTER_DRAIN = false;
    const bf16_t* G; bf16_t* MIX;
    __device__ __forceinline__ void operator()(const f32x4 (&acc)[2][2][4][2], const Unit& u, int wr, int wc, int fr, int fq) const {
        const int row0 = u.pm * BM + wr * 64 + fr, col0 = u.pn * BM + wc * 32 + 8 * fq;
#pragma unroll
        for (int ai = 0; ai < 2; ++ai) {
            u32x4 g[4][2], o[4][2];
#pragma unroll
            for (int m = 0; m < 4; ++m)
#pragma unroll
                for (int bj = 0; bj < 2; ++bj) { const size_t off = (size_t)(row0 + ai * HALF + m * 16) * 1024 + col0 + bj * HALF;
                    g[m][bj] = *(const u32x4*)(G + off); o[m][bj] = (u32x4){0u, 0u, 0u, 0u}; if (ADD) o[m][bj] = *(const u32x4*)(MIX + off); }
#pragma unroll
            for (int m = 0; m < 4; ++m)
#pragma unroll
                for (int bj = 0; bj < 2; ++bj) { const size_t off = (size_t)(row0 + ai * HALF + m * 16) * 1024 + col0 + bj * HALF;
                    const f32x4 a0 = acc[ai][bj][m][0], a1 = acc[ai][bj][m][1]; const u32x4 gg = g[m][bj], oo = o[m][bj];
                    u32x4 w;
                    w.x = cvt_pk_bf16(bf_lo(oo.x) + bf_lo(gg.x) * a0[0], bf_hi(oo.x) + bf_hi(gg.x) * a0[1]);
                    w.y = cvt_pk_bf16(bf_lo(oo.y) + bf_lo(gg.y) * a0[2], bf_hi(oo.y) + bf_hi(gg.y) * a0[3]);
                    w.z = cvt_pk_bf16(bf_lo(oo.z) + bf_lo(gg.z) * a1[0], bf_hi(oo.z) + bf_hi(gg.z) * a1[1]);
                    w.w = cvt_pk_bf16(bf_lo(oo.w) + bf_lo(gg.w) * a1[2], bf_hi(oo.w) + bf_hi(gg.w) * a1[3]);
                    *(u32x4*)(MIX + off) = w; }
            asm volatile("" ::: "memory"); }
    }
};
struct EpiRes {
    static constexpr bool PERM = true, AFTER_DRAIN = false;
    bf16_t* XB; float* ssq;
    __device__ __forceinline__ void operator()(const f32x4 (&acc)[2][2][4][2], const Unit& u, int wr, int wc, int fr, int fq) const {
        const int row0 = u.pm * BM + wr * 64 + fr, col0 = u.pn * BM + wc * 32 + 8 * fq;
#pragma unroll
        for (int ai = 0; ai < 2; ++ai) {
            u32x4 xi[4][2];
#pragma unroll
            for (int m = 0; m < 4; ++m)
#pragma unroll
                for (int bj = 0; bj < 2; ++bj) xi[m][bj] = *(const u32x4*)(XB + (size_t)(row0 + ai * HALF + m * 16) * 1024 + col0 + bj * HALF);
#pragma unroll
            for (int m = 0; m < 4; ++m) { const int row = row0 + ai * HALF + m * 16; float q = 0.f;
#pragma unroll
                for (int bj = 0; bj < 2; ++bj) { const size_t off = (size_t)row * 1024 + col0 + bj * HALF; const u32x4 x = xi[m][bj]; const f32x4 a0 = acc[ai][bj][m][0], a1 = acc[ai][bj][m][1];
                    u32x4 w; w.x = cvt_pk_bf16(bf_lo(x.x) + a0[0], bf_hi(x.x) + a0[1]); w.y = cvt_pk_bf16(bf_lo(x.y) + a0[2], bf_hi(x.y) + a0[3]);
                    w.z = cvt_pk_bf16(bf_lo(x.z) + a1[0], bf_hi(x.z) + a1[1]); w.w = cvt_pk_bf16(bf_lo(x.w) + a1[2], bf_hi(x.w) + a1[3]);
                    *(u32x4*)(XB + off) = w;
                    const float r0 = bf_lo(w.x), r1 = bf_hi(w.x), r2 = bf_lo(w.y), r3 = bf_hi(w.y), r4 = bf_lo(w.z), r5 = bf_hi(w.z), r6 = bf_lo(w.w), r7 = bf_hi(w.w);
                    q += ((r0 * r0 + r1 * r1) + (r2 * r2 + r3 * r3)) + ((r4 * r4 + r5 * r5) + (r6 * r6 + r7 * r7)); }
                q += __shfl_xor(q, 16); q += __shfl_xor(q, 32);
                if (fq == 0) ssq[(size_t)row * 16 + u.pn * 4 + wc] = q; }
            asm volatile("" ::: "memory"); }
    }
};
struct EpiFfn1 {
    static constexpr bool PERM = true, AFTER_DRAIN = false;
    bf16_t* HID; RTab rt;
    __device__ __forceinline__ void operator()(const f32x4 (&acc)[2][2][4][2], const Unit& u, int wr, int wc, int fr, int fq) const {
        const int row0 = u.pm * BM + wr * 64 + fr, col0 = u.pn * 128 + wc * 32 + 8 * fq;
        EPI_ROWS(rs, rt, u, wr, fr)
#pragma unroll
        for (int ai = 0; ai < 2; ++ai)
#pragma unroll
            for (int m = 0; m < 4; ++m) { const float s = rs[ai][m]; float h[8];
#pragma unroll
                for (int n = 0; n < 2; ++n)
#pragma unroll
                    for (int j = 0; j < 4; ++j) { const float g = acc[ai][0][m][n][j] * s, up = acc[ai][1][m][n][j] * s; h[4 * n + j] = g * fsigmoid(g) * up; }
                u32x4 w; w.x = cvt_pk_bf16(h[0], h[1]); w.y = cvt_pk_bf16(h[2], h[3]); w.z = cvt_pk_bf16(h[4], h[5]); w.w = cvt_pk_bf16(h[6], h[7]);
                *(u32x4*)(HID + (size_t)(row0 + ai * HALF + m * 16) * 2816 + col0) = w; }
    }
};

struct EpiO {
    static constexpr bool PERM = true, AFTER_DRAIN = false;
    bf16_t* V; const float* gssq; const float* gn; RTab rt;
    __device__ __forceinline__ void operator()(const f32x4 (&acc)[2][2][4][2], const Unit& u, int wr, int wc, int fr, int fq) const {
        const int row0 = u.pm * BM + wr * 64 + fr, cw = wc * 32 + 8 * fq, col0 = u.pn * BM + cw;
        float hr[2][4];
        { f32x4 hs[2][4];
#pragma unroll
          for (int ai = 0; ai < 2; ++ai)
#pragma unroll
              for (int m = 0; m < 4; ++m) { const float* gq = gssq + (size_t)(u.pn * 16 + 4 * fq) * 32768 + (row0 + ai * HALF + m * 16);
                  hs[ai][m] = (f32x4){gq[0], gq[32768], gq[2 * 32768], gq[3 * 32768]}; }
#pragma unroll
          for (int ai = 0; ai < 2; ++ai)
#pragma unroll
              for (int m = 0; m < 4; ++m) { float t = (hs[ai][m].x + hs[ai][m].y) + (hs[ai][m].z + hs[ai][m].w); t += __shfl_xor(t, 16); t += __shfl_xor(t, 32);
                  hr[ai][m] = __builtin_amdgcn_rsqf(t * (1.0f / 256.0f) + 1e-6f); } }
        asm volatile("" ::: "memory");
        EPI_ROWS(rs, rt, u, wr, fr)
        f32x4 gv[2][2];
#pragma unroll
        for (int bj = 0; bj < 2; ++bj)
#pragma unroll
            for (int n = 0; n < 2; ++n) gv[bj][n] = *(const f32x4*)(gn + cw + bj * HALF + 4 * n);
#pragma unroll
        for (int ai = 0; ai < 2; ++ai)
#pragma unroll
            for (int mp = 0; mp < 2; ++mp) {
                u32x4 xo[2][2];
#pragma unroll
                for (int mm = 0; mm < 2; ++mm)
#pragma unroll
                    for (int bj = 0; bj < 2; ++bj) xo[mm][bj] = *(const u32x4*)(V + (size_t)(row0 + ai * HALF + (2 * mp + mm) * 16) * 1024 + col0 + bj * HALF);
#pragma unroll
                for (int mm = 0; mm < 2; ++mm) { const int m = 2 * mp + mm; const size_t row = (size_t)(row0 + ai * HALF + m * 16); const float h = hr[ai][m], s = rs[ai][m];
#pragma unroll
                    for (int bj = 0; bj < 2; ++bj) { const u32x4 x = xo[mm][bj]; const f32x4 r0 = acc[ai][bj][m][0] * s, r1 = acc[ai][bj][m][1] * s, g0 = gv[bj][0] * h, g1 = gv[bj][1] * h;
                        u32x4 w;
                        w.x = cvt_pk_bf16(bf_lo(x.x) * g0[0] * (r0[0] * fsigmoid(r0[0])), bf_hi(x.x) * g0[1] * (r0[1] * fsigmoid(r0[1])));
                        w.y = cvt_pk_bf16(bf_lo(x.y) * g0[2] * (r0[2] * fsigmoid(r0[2])), bf_hi(x.y) * g0[3] * (r0[3] * fsigmoid(r0[3])));
                        w.z = cvt_pk_bf16(bf_lo(x.z) * g1[0] * (r1[0] * fsigmoid(r1[0])), bf_hi(x.z) * g1[1] * (r1[1] * fsigmoid(r1[1])));
                        w.w = cvt_pk_bf16(bf_lo(x.w) * g1[2] * (r1[2] * fsigmoid(r1[2])), bf_hi(x.w) * g1[3] * (r1[3] * fsigmoid(r1[3])));
                        *(u32x4*)(V + row * 1024 + col0 + bj * HALF) = w; } }
                asm volatile("" ::: "memory"); }
    }
};
struct EpiX {
    static constexpr bool PERM = true, AFTER_DRAIN = false;
    EpiO o; EpiGate g0; EpiGate g1;
    __device__ __forceinline__ void operator()(const f32x4 (&acc)[2][2][4][2], const Unit& u, int wr, int wc, int fr, int fq) const {
        if (u.st == 0) o(acc, u, wr, wc, fr, fq); else if (u.st == 1) g0(acc, u, wr, wc, fr, fq); else g1(acc, u, wr, wc, fr, fq);
    }
};
struct EpiY {
    static constexpr bool PERM = true, AFTER_DRAIN = false;
    EpiMix<0> m0; EpiMix<1> m1;
    __device__ __forceinline__ void operator()(const f32x4 (&acc)[2][2][4][2], const Unit& u, int wr, int wc, int fr, int fq) const {
        if (u.st == 0) m0(acc, u, wr, wc, fr, fq); else m1(acc, u, wr, wc, fr, fq);
    }
};

template <class Epi, class Sched, bool ALIGN_EPI = false, bool SP2 = false, class GemmT = Gemm>
__device__ __forceinline__ void gemm_phase(PG8_LAS unsigned char* lds, const GemmT g, const Sched& S, const Epi& E) {
    int tid_ = threadIdx.x; asm volatile("" : "+v"(tid_));
    const int tid = tid_, wid = __builtin_amdgcn_readfirstlane(tid >> 6), lane = tid & 63, wr = wid >> 2, wc = wid & 3, fr = lane & 15, fq = lane >> 4;
    const int K = g.K, nt = K / BK;
    unsigned voffA[2], voffB[2];
#pragma unroll
    for (int i = 0; i < 2; ++i) { int R, C; stage_rc(tid * 16 + i * 8192, R, C); const int Rb = Epi::PERM ? ((R & ~31) + perm32(R & 31)) : R;
        voffA[i] = (unsigned)(R * K + C) * 2u; voffB[i] = (unsigned)(Rb * K + C) * 2u; }
    const size_t kstep = (size_t)(BK * 2);
    const size_t hstep = (size_t)HALF * K * 2;
    const size_t tstep = 2 * hstep;
    const unsigned ldsw = (unsigned)wid * 1024u;
    const int aoff = lds_byte(wr * 64 + fr, fq * 8), boff = lds_byte(wc * 32 + fr, fq * 8);
#define PG8_SA(b, h) (((b) * 2 + (h)) * HTB)
#define PG8_SB(b, h) ((4 + (b) * 2 + (h)) * HTB)
#define PG8_STAGE(bufoff, gbase, voff) do { _Pragma("unroll") for (int _i = 0; _i < 2; ++_i) \
        __builtin_amdgcn_global_load_lds((const unsigned*)((const char*)(gbase) + (voff)[_i]), (PG8_LAS unsigned*)(lds + (bufoff) + ldsw + _i * 8192), 16, 0, 0); } while (0)
#define PG8_LDA(dst, b, h) do { _Pragma("unroll") for (int m = 0; m < 4; ++m) _Pragma("unroll") for (int k = 0; k < 2; ++k) dst[m][k] = *(const PG8_LAS bf16x8*)(lds + PG8_SA(b, h) + aoff + m * 2048 + k * 1024); } while (0)
#define PG8_LDB(dst, b, h) do { _Pragma("unroll") for (int n = 0; n < 2; ++n) _Pragma("unroll") for (int k = 0; k < 2; ++k) dst[n][k] = *(const PG8_LAS bf16x8*)(lds + PG8_SB(b, h) + boff + n * 2048 + k * 1024); } while (0)
#define PG8_MMA(ai, bj, At, Bt) do { __builtin_amdgcn_s_setprio(1); _Pragma("unroll") for (int m = 0; m < 4; ++m) _Pragma("unroll") for (int n = 0; n < 2; ++n) _Pragma("unroll") for (int k = 0; k < 2; ++k) \
        acc[ai][bj][m][n] = __builtin_amdgcn_mfma_f32_16x16x32_bf16(Bt[n][k], At[m][k], acc[ai][bj][m][n], 0, 0, 0); __builtin_amdgcn_s_setprio(0); } while (0)
#define PG8_WAIT_V(n) asm volatile("s_waitcnt vmcnt(" #n ")" ::: "memory")
#define PG8_WAIT_L(n) asm volatile("s_waitcnt lgkmcnt(" #n ")" ::: "memory")
#define PG8_BAR __builtin_amdgcn_s_barrier()
#define PG8_SCHED __builtin_amdgcn_sched_barrier(0)
    Unit cur, nxt; int ui = 0;
    if (!S.next(0, cur)) return;
    f32x4 acc[2][2][4][2];
#pragma unroll
    for (int a = 0; a < 2; ++a)
#pragma unroll
        for (int b = 0; b < 2; ++b)
#pragma unroll
            for (int m = 0; m < 4; ++m)
#pragma unroll
                for (int n = 0; n < 2; ++n) acc[a][b][m][n] = (f32x4){0.f, 0.f, 0.f, 0.f};
    bf16x8 At[4][2], B0[2][2], B1[2][2];
    const char* cA = (const char*)g.a_of(cur) + (size_t)cur.pm * tstep; const char* cB = (const char*)g.b_of(cur) + (size_t)cur.pn * tstep;
    S.a_ready(cur);
    if constexpr (SP2) {
        PG8_STAGE(PG8_SB(0, 0), cB, voffB); PG8_STAGE(PG8_SB(0, 1), cB + hstep, voffB); PG8_STAGE(PG8_SA(0, 0), cA, voffA); PG8_STAGE(PG8_SA(0, 1), cA + hstep, voffA);
        if (wr == 1) PG8_BAR;
        PG8_WAIT_V(2); PG8_BAR;
        PG8_STAGE(PG8_SB(1, 0), cB + kstep, voffB); PG8_STAGE(PG8_SA(1, 0), cA + kstep, voffA); PG8_STAGE(PG8_SB(1, 1), cB + hstep + kstep, voffB);
        PG8_WAIT_V(6); PG8_BAR;
    } else {
        PG8_STAGE(PG8_SB(0, 0), cB, voffB); PG8_STAGE(PG8_SA(0, 0), cA, voffA); PG8_STAGE(PG8_SB(0, 1), cB + hstep, voffB); PG8_STAGE(PG8_SA(0, 1), cA + hstep, voffA);
        if (wr == 1) PG8_BAR;
        PG8_WAIT_V(4); PG8_BAR;
        PG8_STAGE(PG8_SB(1, 0), cB + kstep, voffB); PG8_STAGE(PG8_SA(1, 0), cA + kstep, voffA); PG8_STAGE(PG8_SB(1, 1), cB + hstep + kstep, voffB);
        PG8_WAIT_V(6); PG8_BAR;
    }
    for (;;) {
        const bool has_next = S.next(ui + 1, nxt);
        const char* nA = has_next ? (const char*)g.a_of(nxt) + (size_t)nxt.pm * tstep : cA; const char* nB = has_next ? (const char*)g.b_of(nxt) + (size_t)nxt.pn * tstep : cB;
        for (int t = 0; t < nt; t += 2) {
            const bool last = (t == nt - 2);
            const char* a1 = cA + (size_t)(t + 1) * kstep;
            const char* a2 = last ? nA : cA + (size_t)(t + 2) * kstep; const char* b2 = last ? nB : cB + (size_t)(t + 2) * kstep;
            const char* a3 = a2 + kstep; const char* b3 = b2 + kstep;
            if (last && has_next) S.a_ready(nxt);
            if constexpr (SP2) {
            PG8_LDB(B0, 0, 0); PG8_LDB(B1, 0, 1); PG8_SCHED; PG8_LDA(At, 0, 0); PG8_STAGE(PG8_SA(1, 1), a1 + hstep, voffA);
            PG8_WAIT_V(8); PG8_WAIT_L(0); PG8_BAR; PG8_MMA(0, 0, At, B0); PG8_MMA(0, 1, At, B1); PG8_BAR; PG8_SCHED;
            PG8_LDA(At, 0, 1); PG8_STAGE(PG8_SB(0, 0), b2, voffB); PG8_STAGE(PG8_SB(0, 1), b2 + hstep, voffB); PG8_STAGE(PG8_SA(0, 0), a2, voffA);
            PG8_WAIT_V(8); PG8_WAIT_L(0); PG8_BAR; PG8_MMA(1, 0, At, B0); PG8_MMA(1, 1, At, B1); PG8_BAR; PG8_SCHED;
            PG8_LDB(B0, 1, 0); PG8_LDB(B1, 1, 1); PG8_SCHED; PG8_LDA(At, 1, 0); PG8_STAGE(PG8_SA(0, 1), a2 + hstep, voffA);
            PG8_WAIT_V(8); PG8_WAIT_L(0); PG8_BAR; PG8_MMA(0, 0, At, B0); PG8_MMA(0, 1, At, B1); PG8_BAR; PG8_SCHED;
            PG8_LDA(At, 1, 1); PG8_STAGE(PG8_SB(1, 0), b3, voffB); PG8_STAGE(PG8_SB(1, 1), b3 + hstep, voffB); PG8_STAGE(PG8_SA(1, 0), a3, voffA);
            PG8_WAIT_V(8); PG8_WAIT_L(0); PG8_BAR; PG8_MMA(1, 0, At, B0); PG8_MMA(1, 1, At, B1); PG8_BAR; PG8_SCHED;
            } else {
            PG8_LDB(B0, 0, 0); PG8_SCHED; PG8_LDA(At, 0, 0); PG8_STAGE(PG8_SA(1, 1), a1 + hstep, voffA);
            PG8_WAIT_L(8); PG8_BAR; PG8_WAIT_L(0); PG8_MMA(0, 0, At, B0); PG8_BAR; PG8_SCHED;
            PG8_LDB(B1, 0, 1); PG8_STAGE(PG8_SB(0, 0), b2, voffB);
            PG8_BAR; PG8_WAIT_L(0); PG8_MMA(0, 1, At, B1); PG8_BAR;
            PG8_LDA(At, 0, 1); PG8_STAGE(PG8_SA(0, 0), a2, voffA);
            PG8_BAR; PG8_WAIT_L(0); PG8_MMA(1, 0, At, B0); PG8_BAR; PG8_SCHED;
            PG8_STAGE(PG8_SB(0, 1), b2 + hstep, voffB);
            PG8_WAIT_V(6); PG8_BAR; PG8_MMA(1, 1, At, B1); PG8_BAR;
            PG8_LDB(B0, 1, 0); PG8_SCHED; PG8_LDA(At, 1, 0); PG8_STAGE(PG8_SA(0, 1), a2 + hstep, voffA);
            PG8_WAIT_L(8); PG8_BAR; PG8_WAIT_L(0); PG8_MMA(0, 0, At, B0); PG8_BAR; PG8_SCHED;
            PG8_LDB(B1, 1, 1); PG8_STAGE(PG8_SB(1, 0), b3, voffB);
            PG8_BAR; PG8_WAIT_L(0); PG8_MMA(0, 1, At, B1); PG8_BAR;
            PG8_LDA(At, 1, 1); PG8_STAGE(PG8_SA(1, 0), a3, voffA);
            PG8_BAR; PG8_WAIT_L(0); PG8_MMA(1, 0, At, B0); PG8_BAR; PG8_SCHED;
            PG8_STAGE(PG8_SB(1, 1), b3 + hstep, voffB);
            PG8_WAIT_V(6); PG8_BAR; PG8_MMA(1, 1, At, B1); PG8_BAR;
            }
        }
        if constexpr (ALIGN_EPI) { if (wr == 0) PG8_BAR; }
        if constexpr (!Epi::AFTER_DRAIN) { E(acc, cur, wr, wc, fr, fq); S.done(cur); }
        if (!has_next) break;
#pragma unroll
        for (int a = 0; a < 2; ++a)
#pragma unroll
            for (int b = 0; b < 2; ++b)
#pragma unroll
                for (int m = 0; m < 4; ++m)
#pragma unroll
                    for (int n = 0; n < 2; ++n) acc[a][b][m][n] = (f32x4){0.f, 0.f, 0.f, 0.f};
        cur = nxt; cA = nA; cB = nB; ++ui;
        if constexpr (ALIGN_EPI) { if (wr == 1) PG8_BAR; }
    }
    PG8_WAIT_V(0);
    if constexpr (!ALIGN_EPI) { if (wr == 0) PG8_BAR; }
    PG8_BAR;
    if constexpr (Epi::AFTER_DRAIN) { E.fused(acc, cur, wr, wc, fr, fq, lds, wid, lane); S.done(cur); }
#undef PG8_SA
#undef PG8_SB
#undef PG8_STAGE
#undef PG8_LDA
#undef PG8_LDB
#undef PG8_MMA
#undef PG8_WAIT_V
#undef PG8_WAIT_L
#undef PG8_BAR
#undef PG8_SCHED
}
}

#define LAS __attribute__((address_space(3)))
typedef unsigned short bf16;
typedef float f32x4 __attribute__((ext_vector_type(4)));
typedef short bf16x8 __attribute__((ext_vector_type(8)));
typedef unsigned v4u __attribute__((ext_vector_type(4)));
typedef unsigned v2u __attribute__((ext_vector_type(2)));

constexpr int M = 32768, D = 1024, SEQ = 4096, NIN = 8208, NIN1 = 6400, FF = 2816, NGU = 5632;
constexpr size_t MiB = 1u << 20;
constexpr size_t WS_W0 = 1 * MiB, WS_WL = 40 * MiB;
constexpr size_t WO_IN = 0, WO_OA = 17 * MiB, WO_OB = 19 * MiB, WO_O = 21 * MiB, WO_GU = 23 * MiB, WO_D = 34 * MiB;
constexpr size_t WS_SSQ = 81 * MiB, WS_GSSQ = 83 * MiB, WS_FZ = 91 * MiB, WS_XB = 96 * MiB, WS_Q = 160 * MiB, WS_K = 192 * MiB, WS_V = 224 * MiB,
                 WS_R = 288 * MiB, WS_U = 352 * MiB, WS_GBIN = 416 * MiB, WS_KDT = 480 * MiB, WS_END = 512 * MiB;
constexpr size_t WS_GAM = 93 * MiB;
constexpr size_t WS_GA = WS_Q, WS_GB = WS_R, WS_HID = WS_Q;
constexpr int LDS_BYTES = 147456;

#define LDS_WAIT() asm volatile("s_waitcnt lgkmcnt(0)" ::: "memory")
__device__ __forceinline__ unsigned f2bf(float f) { unsigned u = __builtin_bit_cast(unsigned, f); return (u + 0x7fffu + ((u >> 16) & 1u)) >> 16; }
__device__ __forceinline__ unsigned pk2(float lo, float hi) { return pg8::cvt_pk_bf16(lo, hi); }
__device__ __forceinline__ float wave_sum(float v) {
#pragma unroll
    for (int o = 1; o < 64; o <<= 1) v += __shfl_xor(v, o);
    return v;
}
__device__ __forceinline__ float bflo(unsigned w) { return __uint_as_float(w << 16); }
__device__ __forceinline__ float bfhi(unsigned w) { return __uint_as_float(w & 0xffff0000u); }
__device__ __forceinline__ void load16(const bf16* p, float (&f)[16]) {
    const v4u a = *(const v4u*)p, b = *(const v4u*)(p + 8);
    f[0] = bflo(a.x); f[1] = bfhi(a.x); f[2] = bflo(a.y); f[3] = bfhi(a.y); f[4] = bflo(a.z); f[5] = bfhi(a.z); f[6] = bflo(a.w); f[7] = bfhi(a.w);
    f[8] = bflo(b.x); f[9] = bfhi(b.x); f[10] = bflo(b.y); f[11] = bfhi(b.y); f[12] = bflo(b.z); f[13] = bfhi(b.z); f[14] = bflo(b.w); f[15] = bfhi(b.w);
}
__device__ __forceinline__ void store16(bf16* p, const float (&f)[16]) {
    v4u a, b; a.x = pk2(f[0], f[1]); a.y = pk2(f[2], f[3]); a.z = pk2(f[4], f[5]); a.w = pk2(f[6], f[7]);
    b.x = pk2(f[8], f[9]); b.y = pk2(f[10], f[11]); b.z = pk2(f[12], f[13]); b.w = pk2(f[14], f[15]);
    *(v4u*)p = a; *(v4u*)(p + 8) = b;
}

__device__ __forceinline__ void load8(const bf16* p, float (&f)[8]) {
    const v4u a = *(const v4u*)p;
    f[0] = bflo(a.x); f[1] = bfhi(a.x); f[2] = bflo(a.y); f[3] = bfhi(a.y); f[4] = bflo(a.z); f[5] = bfhi(a.z); f[6] = bflo(a.w); f[7] = bfhi(a.w);
}
__device__ __forceinline__ void store8(bf16* p, const float (&f)[8]) {
    v4u a; a.x = pk2(f[0], f[1]); a.y = pk2(f[2], f[3]); a.z = pk2(f[4], f[5]); a.w = pk2(f[6], f[7]); *(v4u*)p = a;
}

template <bool GAIN> __device__ __forceinline__ void tr_item_(const float* W, int Nsrc, int col, const float* gain, bf16* WT, int K, int drow0, int k0, LAS float* scr, int lane) {
    const int colc = col >= 0 ? col : 0; const float msk = col >= 0 ? 1.f : 0.f;
    float vv[32];
#pragma unroll
    for (int i = 0; i < 32; ++i) { const int kk = 2 * i + (lane >> 5); vv[i] = W[(size_t)(k0 + kk) * Nsrc + colc]; }
    if (GAIN) {
        float gg[32];
#pragma unroll
        for (int i = 0; i < 32; ++i) gg[i] = gain[k0 + 2 * i + (lane >> 5)];
#pragma unroll
        for (int i = 0; i < 32; ++i) vv[i] *= gg[i];
    }
#pragma unroll
    for (int i = 0; i < 32; ++i) { const int kk = 2 * i + (lane >> 5); scr[kk * 33 + (lane & 31)] = vv[i] * msk; }
    LDS_WAIT(); asm volatile("" ::: "memory");
    const int c = lane & 7;
#pragma unroll
    for (int j = 0; j < 4; ++j) { const int n = (lane >> 3) + 8 * j; const LAS float* s = scr + (8 * c) * 33 + n;
        v4u o; o.x = pk2(s[0 * 33], s[1 * 33]); o.y = pk2(s[2 * 33], s[3 * 33]); o.z = pk2(s[4 * 33], s[5 * 33]); o.w = pk2(s[6 * 33], s[7 * 33]);
        *(v4u*)(WT + (size_t)(drow0 + n) * K + k0 + 8 * c) = o; }
    LDS_WAIT(); asm volatile("" ::: "memory");
}
__device__ __forceinline__ void tr_item(const float* W, int Nsrc, int col, const float* gain, bf16* WT, int K, int drow0, int k0, LAS float* scr, int lane) {
    if (gain) tr_item_<true>(W, Nsrc, col, gain, WT, K, drow0, k0, scr, lane); else tr_item_<false>(W, Nsrc, col, gain, WT, K, drow0, k0, scr, lane);
}
__device__ __forceinline__ int in_src_col(int d) {
    if (d < 3072) return d;
    if (d < 5120) { const int j = (d - 3072) >> 8, i = (d - 3072) & 255; return i < 128 ? 4112 + 128 * j + i : 5136 + 128 * j + (i - 128); }
    if (d < 6144) return 3088 + (d - 5120);
    if (d < 6400) { const int i = d - 6144; return i < 16 ? 3072 + i : -1; }
    return 6160 + (d - 6400);
}

struct Args { const float* in[16]; float* out; unsigned char* ws; };

#define RLX_AGENT __ATOMIC_RELAXED, __HIP_MEMORY_SCOPE_AGENT
#define XB_TMO      128
#define XB_XCNT(j)  (256  + 64 * (j))
#define XB_XSUB(j)  (1280 + 64 * (j))
#define XB_XGEN(j)  (2304 + 64 * (j))
#define XB_TOP      3328
#define XB_TOPGEN   3392
#define XCD_BAR_WORDS 3456
#define XB_SPIN_CAP (1u << 18)

__device__ __forceinline__ unsigned xb_ld(unsigned* p)              { return __hip_atomic_load(p, __ATOMIC_RELAXED, __HIP_MEMORY_SCOPE_AGENT); }
__device__ __forceinline__ unsigned xb_add(unsigned* p, unsigned v) { return __hip_atomic_fetch_add(p, v, __ATOMIC_RELAXED, __HIP_MEMORY_SCOPE_AGENT); }
__device__ __forceinline__ unsigned xb_xcc_id() { return (unsigned)__builtin_amdgcn_s_getreg((3 << 11) | 20) & 0xFu; }
#define XB_SPIN(cond, bar) do { unsigned _sp = 0; while (cond) { __builtin_amdgcn_s_sleep(1); \
    if ((++_sp & 255u) == 0u) { if (xb_ld(&(bar)[XB_TMO])) break; if (_sp > XB_SPIN_CAP) { atomicAdd(&(bar)[XB_TMO], 1u); break; } } } } while (0)

struct XcdBarrier {
    unsigned* bar; unsigned x;
    volatile LAS unsigned* st;
};

__device__ __forceinline__ XcdBarrier xcd_barrier_post(unsigned* bar, volatile LAS unsigned* st) {
    XcdBarrier b; b.bar = bar; b.x = xb_xcc_id(); b.st = st;
    if (threadIdx.x == 0) (void)xb_add(&bar[XB_XCNT(b.x)], 1u);
    return b;
}
__device__ __forceinline__ void xcd_barrier_complete(unsigned* bar, unsigned x, unsigned& nloc, unsigned& nx) {
    const unsigned G = gridDim.x * gridDim.y * gridDim.z;
    unsigned sum, cnt, mine, sp = 0u;
    for (;;) {
        sum = 0u; cnt = 0u; mine = 0u;
#pragma unroll
        for (unsigned j = 0; j < 16; ++j) { const unsigned c = xb_ld(&bar[XB_XCNT(j)]); sum += c; cnt += (c > 0u) ? 1u : 0u; mine = (j == x) ? c : mine; }
        if (sum == G) break;
        __builtin_amdgcn_s_sleep(1);
        if ((++sp & 255u) == 0u) { if (xb_ld(&bar[XB_TMO])) break; if (sp > XB_SPIN_CAP) { atomicAdd(&bar[XB_TMO], 1u); break; } }
    }
    nloc = mine > 0u ? mine : 1u; nx = cnt > 0u ? cnt : 1u;
}

__device__ __forceinline__ void xcd_barrier(const XcdBarrier& b) {
    asm volatile("s_waitcnt vmcnt(0)" ::: "memory");
    __syncthreads();
    if (threadIdx.x == 0) {
        unsigned* bar = b.bar;
        __builtin_amdgcn_s_waitcnt(0);
        unsigned nloc = b.st[0], nx = b.st[1];
        if (nloc == 0u) { xcd_barrier_complete(bar, b.x, nloc, nx); b.st[0] = nloc; b.st[1] = nx; }
        const unsigned old = xb_add(&bar[XB_XSUB(b.x)], 1u);
        const unsigned gen = old / nloc;
        if (old + 1u == (gen + 1u) * nloc) {
            __builtin_amdgcn_fence(__ATOMIC_RELEASE, "agent");
            asm volatile("s_waitcnt vmcnt(0)" ::: "memory");
            const unsigned og = xb_add(&bar[XB_TOP], 1u);
            const unsigned tg = og / nx;
            if (og + 1u == (tg + 1u) * nx) xb_add(&bar[XB_TOPGEN], 1u);
            else XB_SPIN(xb_ld(&bar[XB_TOPGEN]) == tg, bar);
            __builtin_amdgcn_fence(__ATOMIC_ACQUIRE, "agent");
            xb_add(&bar[XB_XGEN(b.x)], 1u);
            asm volatile("s_waitcnt vmcnt(0)" ::: "memory");
        } else {
            XB_SPIN(xb_ld(&bar[XB_XGEN(b.x)]) == gen, bar);
            __builtin_amdgcn_fence(__ATOMIC_ACQUIRE, "agent");
            asm volatile("s_waitcnt vmcnt(0)" ::: "memory");
        }
    }
    __syncthreads();
}

template <int OFF> __device__ __forceinline__ const void* karg_ptr() {
    unsigned long long v; auto k = __builtin_amdgcn_kernarg_segment_ptr();
    asm volatile("s_load_dwordx2 %0, %1, %2\n\ts_waitcnt lgkmcnt(0)" : "=s"(v) : "s"(k), "n"(OFF) : "memory");
    return (const void*)(const __attribute__((address_space(1))) void*)v; }
#define IN_PTR(i) ((const float*)karg_ptr<8 * (i)>())
#define OUT_PTR() ((float*)karg_ptr<128>())
#define WS_PTR() ((unsigned char*)karg_ptr<136>())

__device__ __forceinline__ int otid() { int t = threadIdx.x; asm volatile("" : "+v"(t)); return t; }
__device__ __forceinline__ int obx() { int t = blockIdx.x; asm volatile("" : "+s"(t)); return t; }
__device__ __forceinline__ int ogdim() { int t = gridDim.x; asm volatile("" : "+s"(t)); return t; }

#define LDS_BAR() do { asm volatile("s_waitcnt lgkmcnt(0)" ::: "memory"); __builtin_amdgcn_s_barrier(); asm volatile("" ::: "memory"); } while (0)
__device__ __forceinline__ void gla_pre_item(LAS unsigned char* lds, int item, const bf16* XB, const bf16* Wfz, const float* SSQ, const bf16* Kb, const float* wfg2, const float* bfg, bf16* KDT, float* GAM) {
    const int tid = otid(), lane = tid & 63, w = __builtin_amdgcn_readfirstlane(tid >> 6), l15 = lane & 15, lq = lane >> 4;
    const int b = item >> 6, c = item & 63;
    const size_t row0 = (size_t)b * SEQ + (size_t)c * 64;
    LAS float* fzs = (LAS float*)lds;
    LAS float* tot = (LAS float*)(lds + 4096);
    LAS f32x4* part = (LAS f32x4*)(lds + 8192);
    LAS float* rsd = (LAS float*)(lds + 12288);
    LAS unsigned char* img = lds + 16384;
    const int kcol = tid & 127, tg = tid >> 7;
    { const float* sp = SSQ + (row0 + (tid >> 3)) * 16 + (tid & 7) * 2; float v = sp[0] + sp[1];
      v += __shfl_xor(v, 1); v += __shfl_xor(v, 2); v += __shfl_xor(v, 4);
      if ((tid & 7) == 0) rsd[tid >> 3] = __builtin_amdgcn_rsqf(v * (1.0f / 1024.0f) + 1e-6f); }
    float wfn[16]; float bfn; unsigned short kn[16];
#define PRE_LOAD(hh) do { _Pragma("unroll") for (int r = 0; r < 16; ++r) wfn[r] = wfg2[r * 512 + (hh) * 128 + kcol]; bfn = bfg[(hh) * 128 + kcol]; \
        const bf16* kp_ = Kb + (row0 + tg * 16) * 512 + (hh) * 128 + kcol; _Pragma("unroll") for (int i = 0; i < 16; ++i) kn[i] = kp_[i * 512]; } while (0)
    PRE_LOAD(0);
    { const int mt = w & 3, kh = w >> 2; f32x4 acc = (f32x4){0.f, 0.f, 0.f, 0.f};
      const bf16* ap = XB + (row0 + 16 * mt + l15) * 1024 + 512 * kh + 8 * lq; const bf16* bp = Wfz + (size_t)l15 * 1024 + 512 * kh + 8 * lq;
#pragma unroll
      for (int ks = 0; ks < 16; ++ks) acc = __builtin_amdgcn_mfma_f32_16x16x32_bf16(*(const bf16x8*)(ap + 32 * ks), *(const bf16x8*)(bp + 32 * ks), acc, 0, 0, 0);
      if (kh == 1) part[mt * 64 + lane] = acc;
      LDS_BAR();
      if (kh == 0) { const f32x4 o = part[mt * 64 + lane] + acc;
#pragma unroll
          for (int r = 0; r < 4; ++r) { const int tok = 16 * mt + 4 * lq + r; fzs[tok * 16 + l15] = o[r] * rsd[tok]; } }
      LDS_BAR(); }
#pragma unroll 1
    for (int h = 0; h < 4; ++h) {
        const int it = ((b * 4 + h) << 6) + c;
        if (h > 0) { v4u* dstp = (v4u*)(KDT + (size_t)(it - 64) * 8192); const int p0 = tid, p1 = tid + 512;
            dstp[p0] = *(const LAS v4u*)(img + (p0 >> 3) * 144 + (p0 & 7) * 16); dstp[p1] = *(const LAS v4u*)(img + (p1 >> 3) * 144 + (p1 & 7) * 16); }
        float wf[16]; unsigned short kc[16];
#pragma unroll
        for (int r = 0; r < 16; ++r) { wf[r] = wfn[r]; kc[r] = kn[r]; }
        const float bf = bfn;
        { const int hn = (h < 3) ? h + 1 : 3; PRE_LOAD(hn); }
        float cum[16]; float run = 0.f;
#pragma unroll
        for (int i = 0; i < 16; ++i) { const LAS f32x4* z = (const LAS f32x4*)(fzs + (tg * 16 + i) * 16); float f = bf;
#pragma unroll
            for (int r4 = 0; r4 < 4; ++r4) { const f32x4 zz = z[r4]; f += zz.x * wf[4 * r4] + zz.y * wf[4 * r4 + 1] + zz.z * wf[4 * r4 + 2] + zz.w * wf[4 * r4 + 3]; }
            const float la = (fminf(f, 0.f) - __logf(1.0f + __expf(-fabsf(f)))) * (1.0f / 16.0f);
            run += la; cum[i] = run; }
        tot[tg * 128 + kcol] = run;
        LDS_BAR();
        float pre = 0.f, all = 0.f;
#pragma unroll
        for (int g = 0; g < 4; ++g) { const float tv = tot[g * 128 + kcol]; all += tv; if (g < tg) pre += tv; }
        unsigned pk[8];
#pragma unroll
        for (int i = 0; i < 8; ++i) { const float e0 = __expf(all - (pre + cum[2 * i])), e1 = __expf(all - (pre + cum[2 * i + 1]));
            pk[i] = pk2(__uint_as_float((unsigned)kc[2 * i] << 16) * e0, __uint_as_float((unsigned)kc[2 * i + 1] << 16) * e1); }
        { LAS v4u* dst = (LAS v4u*)(img + kcol * 144 + tg * 32); dst[0] = (v4u){pk[0], pk[1], pk[2], pk[3]}; dst[1] = (v4u){pk[4], pk[5], pk[6], pk[7]}; }
        if (tg == 0) GAM[(size_t)it * 128 + kcol] = __expf(all);
        LDS_BAR();
    }
    { v4u* dstp = (v4u*)(KDT + (size_t)(((b * 4 + 3) << 6) + c) * 8192); const int p0 = tid, p1 = tid + 512;
      dstp[p0] = *(const LAS v4u*)(img + (p0 >> 3) * 144 + (p0 & 7) * 16); dstp[p1] = *(const LAS v4u*)(img + (p1 >> 3) * 144 + (p1 & 7) * 16); }
    LDS_BAR();
#undef PRE_LOAD
}

__device__ __forceinline__ void gla_scan_item(LAS unsigned char* lds, int item, const bf16* Qb, const bf16* Vb, bf16* Ob, const bf16* KDT, const float* GAM, float* GSSQ) {
    const int tid = otid(), lane = tid & 63, w = __builtin_amdgcn_readfirstlane(tid >> 6);
    const int b = item >> 5, h = (item >> 3) & 3, vs = item & 7, bh = b * 4 + h;
    const size_t rb = (size_t)b * SEQ;
    LAS unsigned char* vt = lds;
    LAS unsigned char* st = lds + 4608;
    LAS unsigned char* kdt = lds + 13312;
    LAS unsigned char* qt = lds + 31744;
    f32x4 S0 = (f32x4){0.f, 0.f, 0.f, 0.f}, S1 = (f32x4){0.f, 0.f, 0.f, 0.f};
    const int mt = w >> 1, nt = w & 1, l15 = lane & 15, lq = lane >> 4;
    const int vtok = tid >> 3, vc4 = (tid & 7) * 4;
    const bf16* kdp = KDT + (size_t)bh * 64 * 8192 + (size_t)tid * 8;
    const bf16* qp = Qb + (rb + (tid >> 4)) * 512 + h * 128 + (tid & 15) * 8;
    const float* gp = GAM + (size_t)bh * 64 * 128 + 16 * w + 4 * lq;
    const bf16* vp = Vb + (rb + vtok) * 1024 + h * 256 + vs * 32 + vc4;
    const int kd_dst = (tid >> 3) * 144 + (tid & 7) * 16, q_dst = (tid >> 4) * 272 + (tid & 15) * 16;
    v4u KA[4][2], QA[4][2]; f32x4 G4[4]; v2u VN[4];
#define GLA_LOAD(j, c) do { KA[j][0] = *(const v4u*)(kdp + (size_t)(c) * 8192); KA[j][1] = *(const v4u*)(kdp + (size_t)(c) * 8192 + 4096); \
        QA[j][0] = *(const v4u*)(qp + (size_t)(c) * 64 * 512); QA[j][1] = *(const v4u*)(qp + (size_t)(c) * 64 * 512 + 32 * 512); \
        G4[j] = *(const f32x4*)(gp + (size_t)(c) * 128); VN[j] = *(const v2u*)(vp + (size_t)(c) * 64 * 1024); } while (0)
#pragma unroll
    for (int j = 0; j < 4; ++j) GLA_LOAD(j, j);
#pragma unroll 1
    for (int c0 = 0; c0 < 64; c0 += 4) {
#pragma unroll
        for (int j = 0; j < 4; ++j) {
            const int c = c0 + j; LAS unsigned char* qtc = qt + (j & 1) * 17408;
            { LAS unsigned short* vts = (LAS unsigned short*)vt; const v2u vc = VN[j];
              vts[(vc4 + 0) * 72 + vtok] = (unsigned short)(vc.x & 0xffffu); vts[(vc4 + 1) * 72 + vtok] = (unsigned short)(vc.x >> 16);
              vts[(vc4 + 2) * 72 + vtok] = (unsigned short)(vc.y & 0xffffu); vts[(vc4 + 3) * 72 + vtok] = (unsigned short)(vc.y >> 16);
              *(LAS v4u*)(kdt + kd_dst) = KA[j][0]; *(LAS v4u*)(kdt + kd_dst + 64 * 144) = KA[j][1];
              *(LAS v4u*)(qtc + q_dst) = QA[j][0]; *(LAS v4u*)(qtc + q_dst + 32 * 272) = QA[j][1]; }
            const f32x4 g4 = G4[j];
            { const int cn = (c + 4 < 64) ? c + 4 : 63; GLA_LOAD(j, cn); }
            LDS_BAR();
            { S0 = S0 * g4; S1 = S1 * g4;
#pragma unroll
              for (int ks = 0; ks < 2; ++ks) {
                  const bf16x8 a = *(const LAS bf16x8*)(kdt + (16 * w + l15) * 144 + (8 * lq + 32 * ks) * 2);
                  const bf16x8 b0 = *(const LAS bf16x8*)(vt + l15 * 144 + (8 * lq + 32 * ks) * 2);
                  const bf16x8 b1 = *(const LAS bf16x8*)(vt + (16 + l15) * 144 + (8 * lq + 32 * ks) * 2);
                  S0 = __builtin_amdgcn_mfma_f32_16x16x32_bf16(a, b0, S0, 0, 0, 0);
                  S1 = __builtin_amdgcn_mfma_f32_16x16x32_bf16(a, b1, S1, 0, 0, 0); }
              *(LAS v2u*)(st + l15 * 272 + (16 * w + 4 * lq) * 2) = (v2u){pk2(S0[0], S0[1]), pk2(S0[2], S0[3])};
              *(LAS v2u*)(st + (16 + l15) * 272 + (16 * w + 4 * lq) * 2) = (v2u){pk2(S1[0], S1[1]), pk2(S1[2], S1[3])}; }
            LDS_BAR();
            { f32x4 o = (f32x4){0.f, 0.f, 0.f, 0.f};
#pragma unroll
              for (int ks = 0; ks < 4; ++ks) { const bf16x8 sa = *(const LAS bf16x8*)(st + (16 * nt + l15) * 272 + (8 * lq + 32 * ks) * 2);
                  const bf16x8 qb = *(const LAS bf16x8*)(qtc + (16 * mt + l15) * 272 + (8 * lq + 32 * ks) * 2);
                  o = __builtin_amdgcn_mfma_f32_16x16x32_bf16(sa, qb, o, 0, 0, 0); }
              const size_t row = rb + (size_t)c * 64 + 16 * mt + l15;
              *(v2u*)(Ob + row * 1024 + h * 256 + vs * 32 + 16 * nt + 4 * lq) = (v2u){pk2(o[0], o[1]), pk2(o[2], o[3])};
              float ss = (o[0] * o[0] + o[1] * o[1]) + (o[2] * o[2] + o[3] * o[3]);
              ss += __shfl_xor(ss, 16); ss += __shfl_xor(ss, 32);
              GSSQ[(size_t)(h * 16 + vs * 2 + nt) * M + row] = ss; }
        }
    }
#undef GLA_LOAD
    __syncthreads();
}

__device__ __forceinline__ int fill_rstd(LAS unsigned char* lds, const float* ssq, const pg8::StaticOrder& S) {
    pg8::Unit u0; u0.pm = 0; u0.pn = 0; (void)S.next(0, u0);
    const int tid = otid(); LAS float* tab = (LAS float*)(lds + 131072 + 1024);
    float v[4];
#pragma unroll
    for (int s = 0; s < 4; ++s) { const int pm = (u0.pm + 8 * s < M / 256) ? u0.pm + 8 * s : M / 256 - 1;
        const f32x4* p = (const f32x4*)(ssq + ((size_t)pm * 256 + (tid >> 1)) * 16 + (tid & 1) * 8);
        const f32x4 a = p[0], b = p[1]; v[s] = ((a.x + a.y) + (a.z + a.w)) + ((b.x + b.y) + (b.z + b.w)); }
#pragma unroll
    for (int s = 0; s < 4; ++s) { float t = v[s]; t += __shfl_xor(t, 1);
        if ((tid & 1) == 0) tab[s * 256 + (tid >> 1)] = __builtin_amdgcn_rsqf(t * (1.0f / 1024.0f) + 1e-6f); }
    __syncthreads();
    return u0.pm;
}
#define RTAB(pm0) pg8::RTab{(const LAS float*)(lds + 131072 + 1024), (pm0)}

#ifndef RPT_P1
#define RPT_P1 1
#endif
#ifndef RPT_P4
#define RPT_P4 1
#endif
#ifndef RPT_P6
#define RPT_P6 1
#endif
#ifndef RPT_P8
#define RPT_P8 1
#endif
#ifndef REPS
#define REPS 1
#endif
#define P4_FENCE() do { asm volatile("s_waitcnt vmcnt(0)" ::: "memory"); __builtin_amdgcn_fence(__ATOMIC_ACQUIRE, "agent"); asm volatile("s_waitcnt vmcnt(0)" ::: "memory"); __syncthreads(); } while (0)
#define WSP(T, off) ((T*)(WS_PTR() + (off)))
__global__ void __launch_bounds__(512, 2) fwd_mega(Args a) {
    extern __shared__ __attribute__((aligned(16))) unsigned char lds_raw[];
    cg::grid_group grid = cg::this_grid();
    LAS unsigned char* lds = (LAS unsigned char*)lds_raw;
#define TID (otid())
#define LANE (TID & 63)
#define WAVE (__builtin_amdgcn_readfirstlane(TID >> 6))
#define GDIM (ogdim())
#define BX (obx())
#define VCU ((GDIM % 8 == 0) ? (BX % 8) * (GDIM / 8) + BX / 8 : BX)
#define GW (VCU * 8 + WAVE)
#define NGW (GDIM * 8)

    for (int u = TID; u < (LDS_BYTES - 131072) / 4; u += 512) ((LAS unsigned*)(lds + 131072))[u] = 0u;
    __syncthreads();
    (void)xcd_barrier_post((unsigned*)(WS_PTR() + 16384), (volatile LAS unsigned*)(lds + 131072 + 352));
#define GRID_SYNC() do { XcdBarrier b_; b_.bar = (unsigned*)(WS_PTR() + 16384); b_.x = xb_xcc_id(); b_.st = (volatile LAS unsigned*)(lds + 131072 + 352); xcd_barrier(b_); } while (0)
#pragma unroll 1
    for (int rep = 0; rep < REPS; ++rep) {
#ifndef SKIP_P0
    {
        const int lane = LANE, gw = GW, ngw = NGW;
        unsigned char* ws = WS_PTR();
        LAS float* scr = (LAS float*)(lds + WAVE * 16384);
        constexpr int I_IN = 16 * 264, I_SQ = 512, I_GU = 16 * 176, I_D = 44 * 32, I_L = I_IN + 3 * I_SQ + I_GU + I_D;
        for (int it = gw; it < 2 * I_L; it += ngw) {
            const int l = it / I_L; int r = it % I_L; unsigned char* wb = ws + WS_W0 + (size_t)l * WS_WL;
            if (r < I_IN) { const int kb = r / 264, nb = r % 264; tr_item(IN_PTR(2) + (size_t)l * D * NIN, NIN, in_src_col(nb * 32 + (lane & 31)), IN_PTR(1) + l * D, (bf16*)(wb + WO_IN), D, nb * 32, kb * 64, scr, lane); continue; }
            r -= I_IN;
            if (r < 3 * I_SQ) { const int which = r / I_SQ, r2 = r % I_SQ, kb = r2 / 32, nb = r2 % 32; const float* src = (which == 0 ? IN_PTR(6) : which == 1 ? IN_PTR(9) : IN_PTR(10)) + (size_t)l * D * D;
                tr_item(src, D, nb * 32 + (lane & 31), nullptr, (bf16*)(wb + WO_OA + (size_t)which * 2 * MiB), D, nb * 32, kb * 64, scr, lane); continue; }
            r -= 3 * I_SQ;
            if (r < I_GU) { const int kb = r / 176, nb = r % 176, d0 = nb * 32, j = d0 >> 8, i = d0 & 255; const float* src = (i >= 128 ? IN_PTR(13) : IN_PTR(12)) + (size_t)l * D * FF;
                tr_item(src, FF, 128 * j + (i & 127) + (lane & 31), IN_PTR(11) + l * D, (bf16*)(wb + WO_GU), D, d0, kb * 64, scr, lane); continue; }
            r -= I_GU;
            { const int kb = r / 32, nb = r % 32; tr_item(IN_PTR(14) + (size_t)l * FF * D, D, nb * 32 + (lane & 31), nullptr, (bf16*)(wb + WO_D), FF, nb * 32, kb * 64, scr, lane); }
        }
        const float* x = IN_PTR(0); bf16* XB = (bf16*)(ws + WS_XB); float* SSQ = (float*)(ws + WS_SSQ);
        for (int m = 4 * gw; m < M; m += 4 * ngw) {
            f32x4 v[4][4]; float s[4];
#pragma unroll
            for (int r = 0; r < 4; ++r)
#pragma unroll
                for (int j = 0; j < 4; ++j) v[r][j] = ((const f32x4*)(x + (size_t)(m + r) * D) + lane)[64 * j];
#pragma unroll
            for (int r = 0; r < 4; ++r) { float t = 0.f;
#pragma unroll
                for (int j = 0; j < 4; ++j) t += (v[r][j].x * v[r][j].x + v[r][j].y * v[r][j].y) + (v[r][j].z * v[r][j].z + v[r][j].w * v[r][j].w);
                s[r] = wave_sum(t); }
#pragma unroll
            for (int r = 0; r < 4; ++r) { unsigned long long* o8 = (unsigned long long*)(XB + (size_t)(m + r) * D) + lane;
#pragma unroll
                for (int j = 0; j < 4; ++j) o8[64 * j] = (unsigned long long)pk2(v[r][j].x, v[r][j].y) | ((unsigned long long)pk2(v[r][j].z, v[r][j].w) << 32); }
            SSQ[(size_t)m * 16 + lane] = (lane == 0) ? s[0] : (lane == 16) ? s[1] : (lane == 32) ? s[2] : (lane == 48) ? s[3] : 0.f;
        }
    }
#endif
    asm volatile("s_waitcnt vmcnt(0)" ::: "memory"); grid.sync();
    GRID_SYNC();

#pragma unroll 1
    for (int l = 0; l < 2; ++l) {
#ifndef SKIP_P1
        for (int rp = 0; rp < RPT_P1; ++rp) { unsigned char* ws = WS_PTR();
          pg8::Gemm g{(const bf16*)(ws + WS_XB), (const bf16*)(ws + WS_W0 + (size_t)l * WS_WL + WO_IN), M, 5120, D}; pg8::P1Order S; S.init(M, 5120, GDIM, BX); const int pm0 = fill_rstd(lds, (const float*)(ws + WS_SSQ), S);
          pg8::EpiInProj E{(bf16*)(ws + WS_Q), (bf16*)(ws + WS_K), (bf16*)(ws + WS_V), (bf16*)(ws + WS_R), (bf16*)(ws + WS_U), (bf16*)(ws + WS_GBIN), (float*)(ws + WS_FZ), RTAB(pm0)};
          pg8::gemm_phase<pg8::EpiInProj, pg8::P1Order, true, true>(lds, g, S, E); }
#endif
        GRID_SYNC();
#ifndef SKIP_GLA
        { unsigned char* ws = WS_PTR();
          for (int item = VCU; item < 512; item += GDIM)
              gla_pre_item(lds, item, (const bf16*)(ws + WS_XB), (const bf16*)(ws + WS_W0 + (size_t)l * WS_WL + WO_IN) + (size_t)6144 * D, (const float*)(ws + WS_SSQ), (const bf16*)(ws + WS_K),
                           IN_PTR(3) + (size_t)l * 16 * 512, IN_PTR(4) + l * 512, (bf16*)(ws + WS_KDT), (float*)(ws + WS_GAM)); }
#endif
#ifndef SKIP_CONV
        {
            const int lane = LANE, gw = GW, ngw = NGW;
            unsigned char* ws = WS_PTR(); const bf16* Ub = (const bf16*)(ws + WS_U); bf16* GBIN = (bf16*)(ws + WS_GBIN);
            const float* cw = IN_PTR(7) + (size_t)l * 3 * D; const float* cb = IN_PTR(8) + l * D;
            for (int run = gw; run < M / 8; run += ngw) {
                const int m0 = (run >> 1) * 16, c0 = (run & 1) * 512 + lane * 8;
                float w0[8], w1[8], w2[8], bb[8], um2[8], um1[8];
#pragma unroll
                for (int j = 0; j < 8; ++j) { w0[j] = cw[c0 + j]; w1[j] = cw[D + c0 + j]; w2[j] = cw[2 * D + c0 + j]; bb[j] = cb[c0 + j]; }
                if ((m0 & (SEQ - 1)) == 0) {
#pragma unroll
                    for (int j = 0; j < 8; ++j) { um2[j] = 0.f; um1[j] = 0.f; }
                } else { load8(Ub + (size_t)(m0 - 2) * D + c0, um2); load8(Ub + (size_t)(m0 - 1) * D + c0, um1); }
#pragma unroll 1
                for (int i0 = 0; i0 < 16; i0 += 4) {
                    v4u ur[4], gr[4];
#pragma unroll
                    for (int r = 0; r < 4; ++r) { const size_t off = (size_t)(m0 + i0 + r) * D + c0; ur[r] = *(const v4u*)(Ub + off); gr[r] = *(const v4u*)(GBIN + off); }
#pragma unroll
                    for (int r = 0; r < 4; ++r) { const size_t off = (size_t)(m0 + i0 + r) * D + c0; float u0[8], gg[8], o[8];
                        u0[0] = bflo(ur[r].x); u0[1] = bfhi(ur[r].x); u0[2] = bflo(ur[r].y); u0[3] = bfhi(ur[r].y); u0[4] = bflo(ur[r].z); u0[5] = bfhi(ur[r].z); u0[6] = bflo(ur[r].w); u0[7] = bfhi(ur[r].w);
                        gg[0] = bflo(gr[r].x); gg[1] = bfhi(gr[r].x); gg[2] = bflo(gr[r].y); gg[3] = bfhi(gr[r].y); gg[4] = bflo(gr[r].z); gg[5] = bfhi(gr[r].z); gg[6] = bflo(gr[r].w); gg[7] = bfhi(gr[r].w);
#pragma unroll
                        for (int j = 0; j < 8; ++j) { o[j] = gg[j] * (w0[j] * um2[j] + w1[j] * um1[j] + w2[j] * u0[j] + bb[j]); um2[j] = um1[j]; um1[j] = u0[j]; }
                        store8(GBIN + off, o); }
                }
            }
        }
#endif
        GRID_SYNC();
#ifdef PROBE_SCAN
        { unsigned char* ws = WS_PTR();
          for (int item = VCU; item < 256; item += GDIM)
              gla_scan_item(lds, item, (const bf16*)(ws + WS_Q), (const bf16*)(ws + WS_V), (bf16*)(ws + WS_R), (const bf16*)(ws + WS_KDT), (const float*)(ws + WS_GAM), (float*)(ws + WS_GSSQ)); }
#endif
#ifndef SKIP_GLA
        { unsigned char* ws = WS_PTR();
          for (int item = VCU; item < 256; item += GDIM)
              gla_scan_item(lds, item, (const bf16*)(ws + WS_Q), (const bf16*)(ws + WS_V), (bf16*)(ws + WS_V), (const bf16*)(ws + WS_KDT), (const float*)(ws + WS_GAM), (float*)(ws + WS_GSSQ)); }
#endif
        GRID_SYNC();
#ifndef SKIP_P4
        { unsigned char* ws = WS_PTR(); const bf16* Win = (const bf16*)(ws + WS_W0 + (size_t)l * WS_WL + WO_IN); const bf16* XBp = (const bf16*)(ws + WS_XB);
          pg8::Gemm4 g{XBp, XBp, XBp, XBp, Win + (size_t)2048 * D, Win + (size_t)NIN1 * D, Win + (size_t)(NIN1 + D) * D, Win + (size_t)(NIN1 + D) * D, M, D, D};
          pg8::ChainOrder S; S.init(M, D, GDIM, BX); S.tpw = (M / 256) * (D / 256) / GDIM; S.ns = 3; const int pm0 = fill_rstd(lds, (const float*)(ws + WS_SSQ), S);
          if (S.tpw * GDIM == (M / 256) * (D / 256)) {
          pg8::EpiX E{pg8::EpiO{(bf16*)(ws + WS_V), (const float*)(ws + WS_GSSQ), IN_PTR(5) + l * 256, RTAB(pm0)}, pg8::EpiGate{(bf16*)(ws + WS_GA), RTAB(pm0)}, pg8::EpiGate{(bf16*)(ws + WS_GB), RTAB(pm0)}};
          pg8::gemm_phase<pg8::EpiX, pg8::ChainOrder, true, true, pg8::Gemm4>(lds, g, S, E); } }
#endif
        GRID_SYNC();
#ifndef SKIP_P4
        { unsigned char* ws = WS_PTR();
          const bf16* Ao = (const bf16*)(ws + WS_V); const bf16* Ac = (const bf16*)(ws + WS_GBIN); const bf16* Ba = (const bf16*)(ws + WS_W0 + (size_t)l * WS_WL + WO_OA); const bf16* Bb = (const bf16*)(ws + WS_W0 + (size_t)l * WS_WL + WO_OB);
          pg8::Gemm4 g{Ao, Ac, Ac, Ac, Ba, Bb, Bb, Bb, M, D, D};
          pg8::ChainOrder S; S.init(M, D, GDIM, BX); S.tpw = (M / 256) * (D / 256) / GDIM; S.ns = 2;
          if (S.tpw * GDIM == (M / 256) * (D / 256)) {
          pg8::EpiY E{pg8::EpiMix<0>{(const bf16*)(ws + WS_GA), (bf16*)(ws + WS_GA)}, pg8::EpiMix<1>{(const bf16*)(ws + WS_GB), (bf16*)(ws + WS_GA)}};
          pg8::gemm_phase<pg8::EpiY, pg8::ChainOrder, true, true, pg8::Gemm4>(lds, g, S, E); } }
#endif
        GRID_SYNC();
#ifndef SKIP_P5
        { unsigned char* ws = WS_PTR();
          pg8::Gemm g{(const bf16*)(ws + WS_GA), (const bf16*)(ws + WS_W0 + (size_t)l * WS_WL + WO_O), M, D, D}; pg8::StaticOrder S; S.init(M, D, GDIM, BX);
          pg8::EpiRes E{(bf16*)(ws + WS_XB), (float*)(ws + WS_SSQ)};
          pg8::gemm_phase<pg8::EpiRes, pg8::StaticOrder, true, true>(lds, g, S, E); }
#endif
        GRID_SYNC();
#ifndef SKIP_P6
        for (int rp = 0; rp < RPT_P6; ++rp) { unsigned char* ws = WS_PTR();
          pg8::Gemm g{(const bf16*)(ws + WS_XB), (const bf16*)(ws + WS_W0 + (size_t)l * WS_WL + WO_GU), M, NGU, D}; pg8::StaticOrder S; S.init(M, NGU, GDIM, BX); const int pm0 = fill_rstd(lds, (const float*)(ws + WS_SSQ), S);
          pg8::EpiFfn1 E{(bf16*)(ws + WS_HID), RTAB(pm0)};
          pg8::gemm_phase<pg8::EpiFfn1, pg8::StaticOrder, true, true>(lds, g, S, E); }
#endif
        GRID_SYNC();
#ifndef SKIP_P7
        { unsigned char* ws = WS_PTR();
          pg8::Gemm g{(const bf16*)(ws + WS_HID), (const bf16*)(ws + WS_W0 + (size_t)l * WS_WL + WO_D), M, D, FF}; pg8::StaticOrder S; S.init(M, D, GDIM, BX);
          pg8::EpiRes E{(bf16*)(ws + WS_XB), (float*)(ws + WS_SSQ)};
          pg8::gemm_phase<pg8::EpiRes, pg8::StaticOrder, true, true>(lds, g, S, E); }
#endif
        GRID_SYNC();
    }
    for (int rp8 = 0; rp8 < RPT_P8; ++rp8) {
        const int lane = LANE, gw = GW, ngw = NGW;
        float* out = OUT_PTR(); const float* SSQ = (const float*)(WS_PTR() + WS_SSQ); const bf16* XB = (const bf16*)(WS_PTR() + WS_XB);
        f32x4 g4[4];
#pragma unroll
        for (int j = 0; j < 4; ++j) g4[j] = ((const f32x4*)IN_PTR(15))[64 * j + lane];
        for (int m = 4 * gw; m < M; m += 4 * ngw) {
            float s[4]; v2u xv[4][4];
#pragma unroll
            for (int r = 0; r < 4; ++r) { s[r] = SSQ[(size_t)(m + r) * 16 + (lane & 15)];
#pragma unroll
                for (int j = 0; j < 4; ++j) xv[r][j] = ((const v2u*)(XB + (size_t)(m + r) * D))[64 * j + lane]; }
#pragma unroll
            for (int r = 0; r < 4; ++r) { float t = (lane < 16) ? s[r] : 0.f; t = wave_sum(t);
                const float rstd = __builtin_amdgcn_rsqf(t * (1.0f / 1024.0f) + 1e-6f);
                f32x4* o = (f32x4*)(out + (size_t)(m + r) * D);
#pragma unroll
                for (int j = 0; j < 4; ++j) o[64 * j + lane] = (f32x4){bflo(xv[r][j].x), bfhi(xv[r][j].x), bflo(xv[r][j].y), bfhi(xv[r][j].y)} * rstd * g4[j]; }
        }
    }
    GRID_SYNC();
    }
}

extern "C" void kernel_launch(void* const* d_in, const int* in_sizes, int n_in, void* d_out, int out_size, void* d_ws, size_t ws_size, hipStream_t stream) {
    static int grid = 0;
    if (grid == 0) {
        if (n_in != 16 || in_sizes[0] != M * D || out_size != M * D || ws_size < WS_END) { fprintf(stderr, "kernel_launch: unexpected shapes / workspace (n_in %d, ws %zu)\n", n_in, ws_size); grid = -1; return; }
        int dev = 0, cus = 0, per_cu = 0;
        if (hipGetDevice(&dev) != hipSuccess || hipDeviceGetAttribute(&cus, hipDeviceAttributeMultiprocessorCount, dev) != hipSuccess) { grid = -1; return; }
        if (hipFuncSetAttribute((const void*)fwd_mega, hipFuncAttributeMaxDynamicSharedMemorySize, LDS_BYTES) != hipSuccess) { fprintf(stderr, "kernel_launch: hipFuncSetAttribute failed\n"); grid = -1; return; }
        if (hipOccupancyMaxActiveBlocksPerMultiprocessor(&per_cu, (const void*)fwd_mega, 512, LDS_BYTES) != hipSuccess || per_cu < 1) { fprintf(stderr, "kernel_launch: occupancy query says %d blocks per CU\n", per_cu); per_cu = 1; }
        (void)hipGetLastError();
        grid = cus;
    }
    if (grid < 0) return;
    if (hipMemsetAsync(d_ws, 0, 1 << 20, stream) != hipSuccess) { fprintf(stderr, "kernel_launch: memset of the control words failed\n"); return; }
    Args a{};
    for (int i = 0; i < 16; ++i) a.in[i] = (const float*)d_in[i];
    a.out = (float*)d_out; a.ws = (unsigned char*)d_ws;
    void* args[] = {&a};
    hipError_t e = hipLaunchCooperativeKernel((const void*)fwd_mega, dim3(grid), dim3(512), args, LDS_BYTES, stream);
    if (e != hipSuccess) fprintf(stderr, "kernel_launch: cooperative launch failed: %s (grid %d)\n", hipGetErrorString(e), grid);
}
```

```cpp
#include <hip/hip_runtime.h>
#include <hip/hip_cooperative_groups.h>
#include <cstdio>
#include <cstdint>
namespace cg = cooperative_groups;
namespace pg8 {
#define PG8_LAS __attribute__((address_space(3)))
typedef unsigned short bf16_t;
typedef short bf16x8 __attribute__((ext_vector_type(8)));
typedef float f32x4 __attribute__((ext_vector_type(4)));
typedef unsigned u32x4 __attribute__((ext_vector_type(4)));
constexpr int BM = 256, BK = 64, HALF = 128, HTB = HALF * BK * 2  , STAGE_BYTES = 8 * HTB, NXCD = 8, WGM = 8;

__host__ __device__ __forceinline__ int lds_byte(int r, int c) { const int st = (r >> 4) * 2 + (c >> 5), rr = r & 15, cc = c & 31, ob = rr * 64 + cc * 2; return st * 1024 + (ob ^ (((ob >> 9) & 1) << 5)); }
__host__ __device__ __forceinline__ void stage_rc(int b, int& R, int& C) { const int st = b / 1024, sb = b % 1024, swz = sb ^ (((sb >> 9) & 1) << 5); R = (st >> 1) * 16 + swz / 64; C = (st & 1) * 32 + (swz % 64) / 2; }
__host__ __device__ __forceinline__ int perm32(int rho) { const int n = rho >> 4, i = rho & 15; return 8 * (i >> 2) + 4 * n + (i & 3); }

struct Unit { int pm, pn, st; };
struct Gemm { const bf16_t* A; const bf16_t* Bt; int M, N, K;
    __device__ __forceinline__ const bf16_t* a_of(const Unit&) const { return A; } __device__ __forceinline__ const bf16_t* b_of(const Unit&) const { return Bt; } };
struct Gemm4 { const bf16_t *A0, *A1, *A2, *A3, *B0, *B1, *B2, *B3; int M, N, K;
    __device__ __forceinline__ const bf16_t* a_of(const Unit& u) const { return u.st == 0 ? A0 : u.st == 1 ? A1 : u.st == 2 ? A2 : A3; }
    __device__ __forceinline__ const bf16_t* b_of(const Unit& u) const { return u.st == 0 ? B0 : u.st == 1 ? B1 : u.st == 2 ? B2 : B3; } };

struct StaticOrder {
    int nM, nN, nwg, G, c;
    __host__ __device__ void init(int M, int N, int G_, int c_) { nM = M / BM; nN = N / BM; nwg = nM * nN; G = G_; c = c_; }
    __host__ __device__ bool next(int i, Unit& u) const {
        const long L = (long)i * G + c; if (L >= nwg) return false;
        int wgid = (int)L; { const int q = nwg / NXCD, r = nwg % NXCD, xcd = wgid % NXCD, off = wgid / NXCD; wgid = (xcd < r ? xcd * (q + 1) : r * (q + 1) + (xcd - r) * q) + off; }
        const int nig = WGM * nN, gid = wgid / nig, fm = gid * WGM, gsz = (nM - fm) < WGM ? (nM - fm) : WGM;
        u.pm = fm + ((wgid % nig) % gsz); u.pn = (wgid % nig) / gsz; u.st = 0; return true;
    }
    __device__ __forceinline__ void a_ready(const Unit&) const {}
    __device__ __forceinline__ void done(const Unit&) const {}
};

struct ChainOrder : StaticOrder { int tpw, ns;
    __device__ bool next(int i, Unit& u) const { if (i >= ns * tpw) return false; const bool ok = StaticOrder::next(i / ns, u); u.st = i % ns; return ok; } };
struct P1Order : StaticOrder {
    __device__ bool next(int i, Unit& u) const { const bool ok = StaticOrder::next(i, u); if (u.pn >= 8) u.pn += 4; return ok; } };

typedef float f32x2_t __attribute__((ext_vector_type(2))); typedef __bf16 bf16x2_t __attribute__((ext_vector_type(2)));
__device__ __forceinline__ unsigned cvt_pk_bf16(float lo, float hi) { f32x2_t v = {lo, hi}; bf16x2_t b = __builtin_convertvector(v, bf16x2_t); return __builtin_bit_cast(unsigned, b); }
typedef float f32x2 __attribute__((ext_vector_type(2)));
typedef unsigned u32x2 __attribute__((ext_vector_type(2)));
__device__ __forceinline__ float bf_lo(unsigned w) { return __uint_as_float(w << 16); }
__device__ __forceinline__ float bf_hi(unsigned w) { return __uint_as_float(w & 0xffff0000u); }
__device__ __forceinline__ float fsigmoid(float x) { return __builtin_amdgcn_rcpf(1.0f + __expf(-x)); }
struct RTab { const PG8_LAS float* tab; int pm0; };
#define EPI_ROWS(rs, rt, u, wr, fr) float rs[2][4]; { const PG8_LAS float* rp_ = (rt).tab + (((u).pm - (rt).pm0) >> 3) * 256 + (wr) * 64 + (fr); \
    _Pragma("unroll") for (int ai = 0; ai < 2; ++ai) _Pragma("unroll") for (int m = 0; m < 4; ++m) rs[ai][m] = rp_[ai * HALF + m * 16]; }

struct EpiInProj {
    static constexpr bool PERM = true, AFTER_DRAIN = false;
    bf16_t *Q, *Kb, *V, *R, *U, *GBIN; float* FZ; RTab rt;
    __device__ __forceinline__ void operator()(const f32x4 (&acc)[2][2][4][2], const Unit& u, int wr, int wc, int fr, int fq) const {
        const int row0 = u.pm * BM + wr * 64 + fr, pn = u.pn;
        EPI_ROWS(rs, rt, u, wr, fr)
        if (pn >= 12 && pn < 20) {
            const int col0 = (pn - 12) * 128 + wc * 32 + 8 * fq;
#pragma unroll
            for (int ai = 0; ai < 2; ++ai)
#pragma unroll
                for (int m = 0; m < 4; ++m) { const float s = rs[ai][m] * rs[ai][m];
                    const f32x4 v0 = acc[ai][0][m][0] * acc[ai][1][m][0] * s, v1 = acc[ai][0][m][1] * acc[ai][1][m][1] * s;
                    u32x4 w; w.x = cvt_pk_bf16(v0[0], v0[1]); w.y = cvt_pk_bf16(v0[2], v0[3]); w.z = cvt_pk_bf16(v1[0], v1[1]); w.w = cvt_pk_bf16(v1[2], v1[3]);
                    *(u32x4*)(U + (size_t)(row0 + ai * HALF + m * 16) * 1024 + col0) = w; }
        } else if (pn == 24) {
            if (wc == 0 && fq < 2) {
#pragma unroll
                for (int ai = 0; ai < 2; ++ai)
#pragma unroll
                    for (int m = 0; m < 4; ++m) { float* p = FZ + (size_t)(row0 + ai * HALF + m * 16) * 16 + 8 * fq;
                        *(f32x4*)p = acc[ai][0][m][0] * rs[ai][m]; *(f32x4*)(p + 4) = acc[ai][0][m][1] * rs[ai][m]; }
            }
        } else {
            bf16_t* base; int ldc, colt; float sc = 1.0f;
            if (pn < 2) { base = Q; ldc = 512; colt = pn * 256; sc = 0.08838834764831845f; }
            else if (pn < 4) { base = Kb; ldc = 512; colt = (pn - 2) * 256; }
            else if (pn < 8) { base = V; ldc = 1024; colt = (pn - 4) * 256; }
            else if (pn < 12) { base = R; ldc = 1024; colt = (pn - 8) * 256; }
            else { base = GBIN; ldc = 1024; colt = (pn - 20) * 256; }
            const int col0 = colt + wc * 32 + 8 * fq;
#pragma unroll
            for (int ai = 0; ai < 2; ++ai)
#pragma unroll
                for (int m = 0; m < 4; ++m) { const float s = rs[ai][m] * sc; bf16_t* rowp = base + (size_t)(row0 + ai * HALF + m * 16) * ldc + col0;
#pragma unroll
                    for (int bj = 0; bj < 2; ++bj) { const f32x4 v0 = acc[ai][bj][m][0] * s, v1 = acc[ai][bj][m][1] * s;
                        u32x4 w; w.x = cvt_pk_bf16(v0[0], v0[1]); w.y = cvt_pk_bf16(v0[2], v0[3]); w.z = cvt_pk_bf16(v1[0], v1[1]); w.w = cvt_pk_bf16(v1[2], v1[3]);
                        *(u32x4*)(rowp + bj * HALF) = w; } }
        }
    }
};
struct EpiGate {
    static constexpr bool PERM = true, AFTER_DRAIN = false;
    bf16_t* G; RTab rt;
    __device__ __forceinline__ void operator()(const f32x4 (&acc)[2][2][4][2], const Unit& u, int wr, int wc, int fr, int fq) const {
        const int row0 = u.pm * BM + wr * 64 + fr, col0 = u.pn * BM + wc * 32 + 8 * fq;
        EPI_ROWS(rs, rt, u, wr, fr)
#pragma unroll
        for (int ai = 0; ai < 2; ++ai)
#pragma unroll
            for (int m = 0; m < 4; ++m) { const float s = rs[ai][m]; bf16_t* rowp = G + (size_t)(row0 + ai * HALF + m * 16) * 1024 + col0;
#pragma unroll
                for (int bj = 0; bj < 2; ++bj) { const f32x4 v0 = acc[ai][bj][m][0] * s, v1 = acc[ai][bj][m][1] * s;
                    u32x4 w; w.x = cvt_pk_bf16(fsigmoid(v0[0]), fsigmoid(v0[1])); w.y = cvt_pk_bf16(fsigmoid(v0[2]), fsigmoid(v0[3]));
                    w.z = cvt_pk_bf16(fsigmoid(v1[0]), fsigmoid(v1[1])); w.w = cvt_pk_bf16(fsigmoid(v1[2]), fsigmoid(v1[3]));
                    *(u32x4*)(rowp + bj * HALF) = w; } }
    }
};
template <int ADD> struct EpiMix {
    static constexpr bool PERM = true, AFTER_DRAIN = false;
    const bf16_t* G; bf16_t* MIX;
    __device__ __forceinline__ void operator()(const f32x4 (&acc)[2][2][4][2], const Unit& u, int wr, int wc, int fr, int fq) const {
        const int row0 = u.pm * BM + wr * 64 + fr, col0 = u.pn * BM + wc * 32 + 8 * fq;
#pragma unroll
        for (int ai = 0; ai < 2; ++ai) {
            u32x4 g[4][2], o[4][2];
#pragma unroll
            for (int m = 0; m < 4; ++m)
#pragma unroll
                for (int bj = 0; bj < 2; ++bj) { const size_t off = (size_t)(row0 + ai * HALF + m * 16) * 1024 + col0 + bj * HALF;
                    g[m][bj] = *(const u32x4*)(G + off); o[m][bj] = (u32x4){0u, 0u, 0u, 0u}; if (ADD) o[m][bj] = *(const u32x4*)(MIX + off); }
#pragma unroll
            for (int m = 0; m < 4; ++m)
#pragma unroll
                for (int bj = 0; bj < 2; ++bj) { const size_t off = (size_t)(row0 + ai * HALF + m * 16) * 1024 + col0 + bj * HALF;
                    const f32x4 a0 = acc[ai][bj][m][0], a1 = acc[ai][bj][m][1]; const u32x4 gg = g[m][bj], oo = o[m][bj];
                    u32x4 w;
                    w.x = cvt_pk_bf16(bf_lo(oo.x) + bf_lo(gg.x) * a0[0], bf_hi(oo.x) + bf_hi(gg.x) * a0[1]);
                    w.y = cvt_pk_bf16(bf_lo(oo.y) + bf_lo(gg.y) * a0[2], bf_hi(oo.y) + bf_hi(gg.y) * a0[3]);
                    w.z = cvt_pk_bf16(bf_lo(oo.z) + bf_lo(gg.z) * a1[0], bf_hi(oo.z) + bf_hi(gg.z) * a1[1]);
                    w.w = cvt_pk_bf16(bf_lo(oo.w) + bf_lo(gg.w) * a1[2], bf_hi(oo.w) + bf_hi(gg.w) * a1[3]);
                    *(u32x4*)(MIX + off) = w; }
            asm volatile("" ::: "memory"); }
    }
};
struct EpiRes {
    static constexpr bool PERM = true, AFTER_DRAIN = false;
    bf16_t* XB; float* ssq;
    __device__ __forceinline__ void operator()(const f32x4 (&acc)[2][2][4][2], const Unit& u, int wr, int wc, int fr, int fq) const {
        const int row0 = u.pm * BM + wr * 64 + fr, col0 = u.pn * BM + wc * 32 + 8 * fq;
#pragma unroll
        for (int ai = 0; ai < 2; ++ai) {
            u32x4 xi[4][2];
#pragma unroll
            for (int m = 0; m < 4; ++m)
#pragma unroll
                for (int bj = 0; bj < 2; ++bj) xi[m][bj] = *(const u32x4*)(XB + (size_t)(row0 + ai * HALF + m * 16) * 1024 + col0 + bj * HALF);
#pragma unroll
            for (int m = 0; m < 4; ++m) { const int row = row0 + ai * HALF + m * 16; float q = 0.f;
#pragma unroll
                for (int bj = 0; bj < 2; ++bj) { const size_t off = (size_t)row * 1024 + col0 + bj * HALF; const u32x4 x = xi[m][bj]; const f32x4 a0 = acc[ai][bj][m][0], a1 = acc[ai][bj][m][1];
                    u32x4 w; w.x = cvt_pk_bf16(bf_lo(x.x) + a0[0], bf_hi(x.x) + a0[1]); w.y = cvt_pk_bf16(bf_lo(x.y) + a0[2], bf_hi(x.y) + a0[3]);
                    w.z = cvt_pk_bf16(bf_lo(x.z) + a1[0], bf_hi(x.z) + a1[1]); w.w = cvt_pk_bf16(bf_lo(x.w) + a1[2], bf_hi(x.w) + a1[3]);
                    *(u32x4*)(XB + off) = w;
                    const float r0 = bf_lo(w.x), r1 = bf_hi(w.x), r2 = bf_lo(w.y), r3 = bf_hi(w.y), r4 = bf_lo(w.z), r5 = bf_hi(w.z), r6 = bf_lo(w.w), r7 = bf_hi(w.w);
                    q += ((r0 * r0 + r1 * r1) + (r2 * r2 + r3 * r3)) + ((r4 * r4 + r5 * r5) + (r6 * r6 + r7 * r7)); }
                q += __shfl_xor(q, 16); q += __shfl_xor(q, 32);
                if (fq == 0) ssq[(size_t)row * 16 + u.pn * 4 + wc] = q; }
            asm volatile("" ::: "memory"); }
    }
};
struct EpiFfn1 {
    static constexpr bool PERM = true, AFTER_DRAIN = false;
    bf16_t* HID; RTab rt;
    __device__ __forceinline__ void operator()(const f32x4 (&acc)[2][2][4][2], const Unit& u, int wr, int wc, int fr, int fq) const {
        const int row0 = u.pm * BM + wr * 64 + fr, col0 = u.pn * 128 + wc * 32 + 8 * fq;
        EPI_ROWS(rs, rt, u, wr, fr)
#pragma unroll
        for (int ai = 0; ai < 2; ++ai)
#pragma unroll
            for (int m = 0; m < 4; ++m) { const float s = rs[ai][m]; float h[8];
#pragma unroll
                for (int n = 0; n < 2; ++n)
#pragma unroll
                    for (int j = 0; j < 4; ++j) { const float g = acc[ai][0][m][n][j] * s, up = acc[ai][1][m][n][j] * s; h[4 * n + j] = g * fsigmoid(g) * up; }
                u32x4 w; w.x = cvt_pk_bf16(h[0], h[1]); w.y = cvt_pk_bf16(h[2], h[3]); w.z = cvt_pk_bf16(h[4], h[5]); w.w = cvt_pk_bf16(h[6], h[7]);
                *(u32x4*)(HID + (size_t)(row0 + ai * HALF + m * 16) * 2816 + col0) = w; }
    }
};

struct EpiO {
    static constexpr bool PERM = true, AFTER_DRAIN = false;
    bf16_t* V; const float* gssq; const float* gn; RTab rt;
    __device__ __forceinline__ void operator()(const f32x4 (&acc)[2][2][4][2], const Unit& u, int wr, int wc, int fr, int fq) const {
        const int row0 = u.pm * BM + wr * 64 + fr, cw = wc * 32 + 8 * fq, col0 = u.pn * BM + cw;
        float hr[2][4];
        { f32x4 hs[2][4];
#pragma unroll
          for (int ai = 0; ai < 2; ++ai)
#pragma unroll
              for (int m = 0; m < 4; ++m) { const float* gq = gssq + (size_t)(u.pn * 16 + 4 * fq) * 32768 + (row0 + ai * HALF + m * 16);
                  hs[ai][m] = (f32x4){gq[0], gq[32768], gq[2 * 32768], gq[3 * 32768]}; }
#pragma unroll
          for (int ai = 0; ai < 2; ++ai)
#pragma unroll
              for (int m = 0; m < 4; ++m) { float t = (hs[ai][m].x + hs[ai][m].y) + (hs[ai][m].z + hs[ai][m].w); t += __shfl_xor(t, 16); t += __shfl_xor(t, 32);
                  hr[ai][m] = __builtin_amdgcn_rsqf(t * (1.0f / 256.0f) + 1e-6f); } }
        asm volatile("" ::: "memory");
        EPI_ROWS(rs, rt, u, wr, fr)
        f32x4 gv[2][2];
#pragma unroll
        for (int bj = 0; bj < 2; ++bj)
#pragma unroll
            for (int n = 0; n < 2; ++n) gv[bj][n] = *(const f32x4*)(gn + cw + bj * HALF + 4 * n);
#pragma unroll
        for (int ai = 0; ai < 2; ++ai)
#pragma unroll
            for (int mp = 0; mp < 2; ++mp) {
                u32x4 xo[2][2];
#pragma unroll
                for (int mm = 0; mm < 2; ++mm)
#pragma unroll
                    for (int bj = 0; bj < 2; ++bj) xo[mm][bj] = *(const u32x4*)(V + (size_t)(row0 + ai * HALF + (2 * mp + mm) * 16) * 1024 + col0 + bj * HALF);
#pragma unroll
                for (int mm = 0; mm < 2; ++mm) { const int m = 2 * mp + mm; const size_t row = (size_t)(row0 + ai * HALF + m * 16); const float h = hr[ai][m], s = rs[ai][m];
#pragma unroll
                    for (int bj = 0; bj < 2; ++bj) { const u32x4 x = xo[mm][bj]; const f32x4 r0 = acc[ai][bj][m][0] * s, r1 = acc[ai][bj][m][1] * s, g0 = gv[bj][0] * h, g1 = gv[bj][1] * h;
                        u32x4 w;
                        w.x = cvt_pk_bf16(bf_lo(x.x) * g0[0] * (r0[0] * fsigmoid(r0[0])), bf_hi(x.x) * g0[1] * (r0[1] * fsigmoid(r0[1])));
                        w.y = cvt_pk_bf16(bf_lo(x.y) * g0[2] * (r0[2] * fsigmoid(r0[2])), bf_hi(x.y) * g0[3] * (r0[3] * fsigmoid(r0[3])));
                        w.z = cvt_pk_bf16(bf_lo(x.z) * g1[0] * (r1[0] * fsigmoid(r1[0])), bf_hi(x.z) * g1[1] * (r1[1] * fsigmoid(r1[1])));
                        w.w = cvt_pk_bf16(bf_lo(x.w) * g1[2] * (r1[2] * fsigmoid(r1[2])), bf_hi(x.w) * g1[3] * (r1[3] * fsigmoid(r1[3])));
                        *(u32x4*)(V + row * 1024 + col0 + bj * HALF) = w; } }
                asm volatile("" ::: "memory"); }
    }
};
struct EpiX {
    static constexpr bool PERM = true, AFTER_DRAIN = false;
    EpiO o; EpiGate g0; EpiGate g1;
    __device__ __forceinline__ void operator()(const f32x4 (&acc)[2][2][4][2], const Unit& u, int wr, int wc, int fr, int fq) const {
        if (u.st == 0) o(acc, u, wr, wc, fr, fq); else if (u.st == 1) g0(acc, u, wr, wc, fr, fq); else g1(acc, u, wr, wc, fr, fq);
    }
};
struct EpiY {
    static constexpr bool PERM = true, AFTER_DRAIN = false;
    EpiMix<0> m0; EpiMix<1> m1;
    __device__ __forceinline__ void operator()(const f32x4 (&acc)[2][2][4][2], const Unit& u, int wr, int wc, int fr, int fq) const {
        if (u.st == 0) m0(acc, u, wr, wc, fr, fq); else m1(acc, u, wr, wc, fr, fq);
    }
};

template <class Epi, class Sched, bool ALIGN_EPI = false, bool SP2 = false, class GemmT = Gemm>
__device__ __forceinline__ void gemm_phase(PG8_LAS unsigned char* lds, const GemmT g, const Sched& S, const Epi& E) {
    int tid_ = threadIdx.x; asm volatile("" : "+v"(tid_));
    const int tid = tid_, wid = __builtin_amdgcn_readfirstlane(tid >> 6), lane = tid & 63, wr = wid >> 2, wc = wid & 3, fr = lane & 15, fq = lane >> 4;
    const int K = g.K, nt = K / BK;
    unsigned voffA[2], voffB[2];
#pragma unroll
    for (int i = 0; i < 2; ++i) { int R, C; stage_rc(tid * 16 + i * 8192, R, C); const int Rb = Epi::PERM ? ((R & ~31) + perm32(R & 31)) : R;
        voffA[i] = (unsigned)(R * K + C) * 2u; voffB[i] = (unsigned)(Rb * K + C) * 2u; }
    const size_t kstep = (size_t)(BK * 2);
    const size_t hstep = (size_t)HALF * K * 2;
    const size_t tstep = 2 * hstep;
    const unsigned ldsw = (unsigned)wid * 1024u;
    const int aoff = lds_byte(wr * 64 + fr, fq * 8), boff = lds_byte(wc * 32 + fr, fq * 8);
#define PG8_SA(b, h) (((b) * 2 + (h)) * HTB)
#define PG8_SB(b, h) ((4 + (b) * 2 + (h)) * HTB)
#define PG8_STAGE(bufoff, gbase, voff) do { _Pragma("unroll") for (int _i = 0; _i < 2; ++_i) \
        __builtin_amdgcn_global_load_lds((const unsigned*)((const char*)(gbase) + (voff)[_i]), (PG8_LAS unsigned*)(lds + (bufoff) + ldsw + _i * 8192), 16, 0, 0); } while (0)
#define PG8_LDA(dst, b, h) do { _Pragma("unroll") for (int m = 0; m < 4; ++m) _Pragma("unroll") for (int k = 0; k < 2; ++k) dst[m][k] = *(const PG8_LAS bf16x8*)(lds + PG8_SA(b, h) + aoff + m * 2048 + k * 1024); } while (0)
#define PG8_LDB(dst, b, h) do { _Pragma("unroll") for (int n = 0; n < 2; ++n) _Pragma("unroll") for (int k = 0; k < 2; ++k) dst[n][k] = *(const PG8_LAS bf16x8*)(lds + PG8_SB(b, h) + boff + n * 2048 + k * 1024); } while (0)
#define PG8_MMA(ai, bj, At, Bt) do { __builtin_amdgcn_s_setprio(1); _Pragma("unroll") for (int m = 0; m < 4; ++m) _Pragma("unroll") for (int n = 0; n < 2; ++n) _Pragma("unroll") for (int k = 0; k < 2; ++k) \
        acc[ai][bj][m][n] = __builtin_amdgcn_mfma_f32_16x16x32_bf16(Bt[n][k], At[m][k], acc[ai][bj][m][n], 0, 0, 0); __builtin_amdgcn_s_setprio(0); } while (0)
#define PG8_WAIT_V(n) asm volatile("s_waitcnt vmcnt(" #n ")" ::: "memory")
#define PG8_WAIT_L(n) asm volatile("s_waitcnt lgkmcnt(" #n ")" ::: "memory")
#define PG8_BAR __builtin_amdgcn_s_barrier()
#define PG8_SCHED __builtin_amdgcn_sched_barrier(0)
    Unit cur, nxt; int ui = 0;
    if (!S.next(0, cur)) return;
    f32x4 acc[2][2][4][2];
#pragma unroll
    for (int a = 0; a < 2; ++a)
#pragma unroll
        for (int b = 0; b < 2; ++b)
#pragma unroll
            for (int m = 0; m < 4; ++m)
#pragma unroll
                for (int n = 0; n < 2; ++n) acc[a][b][m][n] = (f32x4){0.f, 0.f, 0.f, 0.f};
    bf16x8 At[4][2], B0[2][2], B1[2][2];
    const char* cA = (const char*)g.a_of(cur) + (size_t)cur.pm * tstep; const char* cB = (const char*)g.b_of(cur) + (size_t)cur.pn * tstep;
    S.a_ready(cur);
    if constexpr (SP2) {
        PG8_STAGE(PG8_SB(0, 0), cB, voffB); PG8_STAGE(PG8_SB(0, 1), cB + hstep, voffB); PG8_STAGE(PG8_SA(0, 0), cA, voffA); PG8_STAGE(PG8_SA(0, 1), cA + hstep, voffA);
        if (wr == 1) PG8_BAR;
        PG8_WAIT_V(2); PG8_BAR;
        PG8_STAGE(PG8_SB(1, 0), cB + kstep, voffB); PG8_STAGE(PG8_SA(1, 0), cA + kstep, voffA); PG8_STAGE(PG8_SB(1, 1), cB + hstep + kstep, voffB);
        PG8_WAIT_V(6); PG8_BAR;
    } else {
        PG8_STAGE(PG8_SB(0, 0), cB, voffB); PG8_STAGE(PG8_SA(0, 0), cA, voffA); PG8_STAGE(PG8_SB(0, 1), cB + hstep, voffB); PG8_STAGE(PG8_SA(0, 1), cA + hstep, voffA);
        if (wr == 1) PG8_BAR;
        PG8_WAIT_V(4); PG8_BAR;
        PG8_STAGE(PG8_SB(1, 0), cB + kstep, voffB); PG8_STAGE(PG8_SA(1, 0), cA + kstep, voffA); PG8_STAGE(PG8_SB(1, 1), cB + hstep + kstep, voffB);
        PG8_WAIT_V(6); PG8_BAR;
    }
    for (;;) {
        const bool has_next = S.next(ui + 1, nxt);
        const char* nA = has_next ? (const char*)g.a_of(nxt) + (size_t)nxt.pm * tstep : cA; const char* nB = has_next ? (const char*)g.b_of(nxt) + (size_t)nxt.pn * tstep : cB;
        for (int t = 0; t < nt; t += 2) {
            const bool last = (t == nt - 2);
            const char* a1 = cA + (size_t)(t + 1) * kstep;
            const char* a2 = last ? nA : cA + (size_t)(t + 2) * kstep; const char* b2 = last ? nB : cB + (size_t)(t + 2) * kstep;
            const char* a3 = a2 + kstep; const char* b3 = b2 + kstep;
            if (last && has_next) S.a_ready(nxt);
            if constexpr (SP2) {
            PG8_LDB(B0, 0, 0); PG8_LDB(B1, 0, 1); PG8_SCHED; PG8_LDA(At, 0, 0); PG8_STAGE(PG8_SA(1, 1), a1 + hstep, voffA);
            PG8_WAIT_V(8); PG8_WAIT_L(0); PG8_BAR; PG8_MMA(0, 0, At, B0); PG8_MMA(0, 1, At, B1); PG8_BAR; PG8_SCHED;
            PG8_LDA(At, 0, 1); PG8_STAGE(PG8_SB(0, 0), b2, voffB); PG8_STAGE(PG8_SB(0, 1), b2 + hstep, voffB); PG8_STAGE(PG8_SA(0, 0), a2, voffA);
            PG8_WAIT_V(8); PG8_WAIT_L(0); PG8_BAR; PG8_MMA(1, 0, At, B0); PG8_MMA(1, 1, At, B1); PG8_BAR; PG8_SCHED;
            PG8_LDB(B0, 1, 0); PG8_LDB(B1, 1, 1); PG8_SCHED; PG8_LDA(At, 1, 0); PG8_STAGE(PG8_SA(0, 1), a2 + hstep, voffA);
            PG8_WAIT_V(8); PG8_WAIT_L(0); PG8_BAR; PG8_MMA(0, 0, At, B0); PG8_MMA(0, 1, At, B1); PG8_BAR; PG8_SCHED;
            PG8_LDA(At, 1, 1); PG8_STAGE(PG8_SB(1, 0), b3, voffB); PG8_STAGE(PG8_SB(1, 1), b3 + hstep, voffB); PG8_STAGE(PG8_SA(1, 0), a3, voffA);
            PG8_WAIT_V(8); PG8_WAIT_L(0); PG8_BAR; PG8_MMA(1, 0, At, B0); PG8_MMA(1, 1, At, B1); PG8_BAR; PG8_SCHED;
            } else {
            PG8_LDB(B0, 0, 0); PG8_SCHED; PG8_LDA(At, 0, 0); PG8_STAGE(PG8_SA(1, 1), a1 + hstep, voffA);
            PG8_WAIT_L(8); PG8_BAR; PG8_WAIT_L(0); PG8_MMA(0, 0, At, B0); PG8_BAR; PG8_SCHED;
            PG8_LDB(B1, 0, 1); PG8_STAGE(PG8_SB(0, 0), b2, voffB);
            PG8_BAR; PG8_WAIT_L(0); PG8_MMA(0, 1, At, B1); PG8_BAR;
            PG8_LDA(At, 0, 1); PG8_STAGE(PG8_SA(0, 0), a2, voffA);
            PG8_BAR; PG8_WAIT_L(0); PG8_MMA(1, 0, At, B0); PG8_BAR; PG8_SCHED;
            PG8_STAGE(PG8_SB(0, 1), b2 + hstep, voffB);
            PG8_WAIT_V(6); PG8_BAR; PG8_MMA(1, 1, At, B1); PG8_BAR;
            PG8_LDB(B0, 1, 0); PG8_SCHED; PG8_LDA(At, 1, 0); PG8_STAGE(PG8_SA(0, 1), a2 + hstep, voffA);
            PG8_WAIT_L(8); PG8_BAR; PG8_WAIT_L(0); PG8_MMA(0, 0, At, B0); PG8_BAR; PG8_SCHED;
            PG8_LDB(B1, 1, 1); PG8_STAGE(PG8_SB(1, 0), b3, voffB);
            PG8_BAR; PG8_WAIT_L(0); PG8_MMA(0, 1, At, B1); PG8_BAR;
            PG8_LDA(At, 1, 1); PG8_STAGE(PG8_SA(1, 0), a3, voffA);
            PG8_BAR; PG8_WAIT_L(0); PG8_MMA(1, 0, At, B0); PG8_BAR; PG8_SCHED;
            PG8_STAGE(PG8_SB(1, 1), b3 + hstep, voffB);
            PG8_WAIT_V(6); PG8_BAR; PG8_MMA(1, 1, At, B1); PG8_BAR;
            }
        }
        if constexpr (ALIGN_EPI) { if (wr == 0) PG8_BAR; }
        if constexpr (!Epi::AFTER_DRAIN) { E(acc, cur, wr, wc, fr, fq); S.done(cur); }
        if (!has_next) break;
#pragma unroll
        for (int a = 0; a < 2; ++a)
#pragma unroll
            for (int b = 0; b < 2; ++b)
#pragma unroll
                for (int m = 0; m < 4; ++m)
#pragma unroll
                    for (int n = 0; n < 2; ++n) acc[a][b][m][n] = (f32x4){0.f, 0.f, 0.f, 0.f};
        cur = nxt; cA = nA; cB = nB; ++ui;
        if constexpr (ALIGN_EPI) { if (wr == 1) PG8_BAR; }
    }
    PG8_WAIT_V(0);
    if constexpr (!ALIGN_EPI) { if (wr == 0) PG8_BAR; }
    PG8_BAR;
    if constexpr (Epi::AFTER_DRAIN) { E.fused(acc, cur, wr, wc, fr, fq, lds, wid, lane); S.done(cur); }
#undef PG8_SA
#undef PG8_SB
#undef PG8_STAGE
#undef PG8_LDA
#undef PG8_LDB
#undef PG8_MMA
#undef PG8_WAIT_V
#undef PG8_WAIT_L
#undef PG8_BAR
#undef PG8_SCHED
}
}

#define LAS __attribute__((address_space(3)))
typedef unsigned short bf16;
typedef float f32x4 __attribute__((ext_vector_type(4)));
typedef short bf16x8 __attribute__((ext_vector_type(8)));
typedef unsigned v4u __attribute__((ext_vector_type(4)));
typedef unsigned v2u __attribute__((ext_vector_type(2)));

constexpr int M = 32768, D = 1024, SEQ = 4096, NIN = 8208, NIN1 = 6400, FF = 2816, NGU = 5632;
constexpr size_t MiB = 1u << 20;
constexpr size_t WS_W0 = 1 * MiB, WS_WL = 40 * MiB;
constexpr size_t WO_IN = 0, WO_OA = 17 * MiB, WO_OB = 19 * MiB, WO_O = 21 * MiB, WO_GU = 23 * MiB, WO_D = 34 * MiB;
constexpr size_t WS_SSQ = 81 * MiB, WS_GSSQ = 83 * MiB, WS_FZ = 91 * MiB, WS_XB = 96 * MiB, WS_Q = 160 * MiB, WS_K = 192 * MiB, WS_V = 224 * MiB,
                 WS_R = 288 * MiB, WS_U = 352 * MiB, WS_GBIN = 416 * MiB, WS_KDT = 480 * MiB, WS_END = 512 * MiB;
constexpr size_t WS_GAM = 93 * MiB;
constexpr size_t WS_GA = WS_Q, WS_GB = WS_R, WS_HID = WS_Q;
constexpr int LDS_BYTES = 147456;

#define LDS_WAIT() asm volatile("s_waitcnt lgkmcnt(0)" ::: "memory")
__device__ __forceinline__ unsigned f2bf(float f) { unsigned u = __builtin_bit_cast(unsigned, f); return (u + 0x7fffu + ((u >> 16) & 1u)) >> 16; }
__device__ __forceinline__ unsigned pk2(float lo, float hi) { return pg8::cvt_pk_bf16(lo, hi); }
__device__ __forceinline__ float wave_sum(float v) {
#pragma unroll
    for (int o = 1; o < 64; o <<= 1) v += __shfl_xor(v, o);
    return v;
}
__device__ __forceinline__ float bflo(unsigned w) { return __uint_as_float(w << 16); }
__device__ __forceinline__ float bfhi(unsigned w) { return __uint_as_float(w & 0xffff0000u); }
__device__ __forceinline__ void load16(const bf16* p, float (&f)[16]) {
    const v4u a = *(const v4u*)p, b = *(const v4u*)(p + 8);
    f[0] = bflo(a.x); f[1] = bfhi(a.x); f[2] = bflo(a.y); f[3] = bfhi(a.y); f[4] = bflo(a.z); f[5] = bfhi(a.z); f[6] = bflo(a.w); f[7] = bfhi(a.w);
    f[8] = bflo(b.x); f[9] = bfhi(b.x); f[10] = bflo(b.y); f[11] = bfhi(b.y); f[12] = bflo(b.z); f[13] = bfhi(b.z); f[14] = bflo(b.w); f[15] = bfhi(b.w);
}
__device__ __forceinline__ void store16(bf16* p, const float (&f)[16]) {
    v4u a, b; a.x = pk2(f[0], f[1]); a.y = pk2(f[2], f[3]); a.z = pk2(f[4], f[5]); a.w = pk2(f[6], f[7]);
    b.x = pk2(f[8], f[9]); b.y = pk2(f[10], f[11]); b.z = pk2(f[12], f[13]); b.w = pk2(f[14], f[15]);
    *(v4u*)p = a; *(v4u*)(p + 8) = b;
}

__device__ __forceinline__ void load8(const bf16* p, float (&f)[8]) {
    const v4u a = *(const v4u*)p;
    f[0] = bflo(a.x); f[1] = bfhi(a.x); f[2] = bflo(a.y); f[3] = bfhi(a.y); f[4] = bflo(a.z); f[5] = bfhi(a.z); f[6] = bflo(a.w); f[7] = bfhi(a.w);
}
__device__ __forceinline__ void store8(bf16* p, const float (&f)[8]) {
    v4u a; a.x = pk2(f[0], f[1]); a.y = pk2(f[2], f[3]); a.z = pk2(f[4], f[5]); a.w = pk2(f[6], f[7]); *(v4u*)p = a;
}

template <bool GAIN> __device__ __forceinline__ void tr_item_(const float* W, int Nsrc, int col, const float* gain, bf16* WT, int K, int drow0, int k0, LAS float* scr, int lane) {
    const int colc = col >= 0 ? col : 0; const float msk = col >= 0 ? 1.f : 0.f;
    float vv[32];
#pragma unroll
    for (int i = 0; i < 32; ++i) { const int kk = 2 * i + (lane >> 5); vv[i] = W[(size_t)(k0 + kk) * Nsrc + colc]; }
    if (GAIN) {
        float gg[32];
#pragma unroll
        for (int i = 0; i < 32; ++i) gg[i] = gain[k0 + 2 * i + (lane >> 5)];
#pragma unroll
        for (int i = 0; i < 32; ++i) vv[i] *= gg[i];
    }
#pragma unroll
    for (int i = 0; i < 32; ++i) { const int kk = 2 * i + (lane >> 5); scr[kk * 33 + (lane & 31)] = vv[i] * msk; }
    LDS_WAIT(); asm volatile("" ::: "memory");
    const int c = lane & 7;
#pragma unroll
    for (int j = 0; j < 4; ++j) { const int n = (lane >> 3) + 8 * j; const LAS float* s = scr + (8 * c) * 33 + n;
        v4u o; o.x = pk2(s[0 * 33], s[1 * 33]); o.y = pk2(s[2 * 33], s[3 * 33]); o.z = pk2(s[4 * 33], s[5 * 33]); o.w = pk2(s[6 * 33], s[7 * 33]);
        *(v4u*)(WT + (size_t)(drow0 + n) * K + k0 + 8 * c) = o; }
    LDS_WAIT(); asm volatile("" ::: "memory");
}
__device__ __forceinline__ void tr_item(const float* W, int Nsrc, int col, const float* gain, bf16* WT, int K, int drow0, int k0, LAS float* scr, int lane) {
    if (gain) tr_item_<true>(W, Nsrc, col, gain, WT, K, drow0, k0, scr, lane); else tr_item_<false>(W, Nsrc, col, gain, WT, K, drow0, k0, scr, lane);
}
__device__ __forceinline__ int in_src_col(int d) {
    if (d < 3072) return d;
    if (d < 5120) { const int j = (d - 3072) >> 8, i = (d - 3072) & 255; return i < 128 ? 4112 + 128 * j + i : 5136 + 128 * j + (i - 128); }
    if (d < 6144) return 3088 + (d - 5120);
    if (d < 6400) { const int i = d - 6144; return i < 16 ? 3072 + i : -1; }
    return 6160 + (d - 6400);
}

struct Args { const float* in[16]; float* out; unsigned char* ws; };

#define RLX_AGENT __ATOMIC_RELAXED, __HIP_MEMORY_SCOPE_AGENT
#define XB_TMO      128
#define XB_XCNT(j)  (256  + 64 * (j))
#define XB_XSUB(j)  (1280 + 64 * (j))
#define XB_XGEN(j)  (2304 + 64 * (j))
#define XB_TOP      3328
#define XB_TOPGEN   3392
#define XCD_BAR_WORDS 3456
#define XB_SPIN_CAP (1u << 18)

__device__ __forceinline__ unsigned xb_ld(unsigned* p)              { return __hip_atomic_load(p, __ATOMIC_RELAXED, __HIP_MEMORY_SCOPE_AGENT); }
__device__ __forceinline__ unsigned xb_add(unsigned* p, unsigned v) { return __hip_atomic_fetch_add(p, v, __ATOMIC_RELAXED, __HIP_MEMORY_SCOPE_AGENT); }
__device__ __forceinline__ unsigned xb_xcc_id() { return (unsigned)__builtin_amdgcn_s_getreg((3 << 11) | 20) & 0xFu; }
#define XB_SPIN(cond, bar) do { unsigned _sp = 0; while (cond) { __builtin_amdgcn_s_sleep(1); \
    if ((++_sp & 255u) == 0u) { if (xb_ld(&(bar)[XB_TMO])) break; if (_sp > XB_SPIN_CAP) { atomicAdd(&(bar)[XB_TMO], 1u); break; } } } } while (0)

struct XcdBarrier {
    unsigned* bar; unsigned x;
    volatile LAS unsigned* st;
};

__device__ __forceinline__ XcdBarrier xcd_barrier_post(unsigned* bar, volatile LAS unsigned* st) {
    XcdBarrier b; b.bar = bar; b.x = xb_xcc_id(); b.st = st;
    if (threadIdx.x == 0) (void)xb_add(&bar[XB_XCNT(b.x)], 1u);
    return b;
}
__device__ __forceinline__ void xcd_barrier_complete(unsigned* bar, unsigned x, unsigned& nloc, unsigned& nx) {
    const unsigned G = gridDim.x * gridDim.y * gridDim.z;
    unsigned sum, cnt, mine, sp = 0u;
    for (;;) {
        sum = 0u; cnt = 0u; mine = 0u;
#pragma unroll
        for (unsigned j = 0; j < 16; ++j) { const unsigned c = xb_ld(&bar[XB_XCNT(j)]); sum += c; cnt += (c > 0u) ? 1u : 0u; mine = (j == x) ? c : mine; }
        if (sum == G) break;
        __builtin_amdgcn_s_sleep(1);
        if ((++sp & 255u) == 0u) { if (xb_ld(&bar[XB_TMO])) break; if (sp > XB_SPIN_CAP) { atomicAdd(&bar[XB_TMO], 1u); break; } }
    }
    nloc = mine > 0u ? mine : 1u; nx = cnt > 0u ? cnt : 1u;
}

__device__ __forceinline__ void xcd_barrier(const XcdBarrier& b) {
    asm volatile("s_waitcnt vmcnt(0)" ::: "memory");
    __syncthreads();
    if (threadIdx.x == 0) {
        unsigned* bar = b.bar;
        __builtin_amdgcn_s_waitcnt(0);
        unsigned nloc = b.st[0], nx = b.st[1];
        if (nloc == 0u) { xcd_barrier_complete(bar, b.x, nloc, nx); b.st[0] = nloc; b.st[1] = nx; }
        const unsigned old = xb_add(&bar[XB_XSUB(b.x)], 1u);
        const unsigned gen = old / nloc;
        if (old + 1u == (gen + 1u) * nloc) {
            __builtin_amdgcn_fence(__ATOMIC_RELEASE, "agent");
            asm volatile("s_waitcnt vmcnt(0)" ::: "memory");
            const unsigned og = xb_add(&bar[XB_TOP], 1u);
            const unsigned tg = og / nx;
            if (og + 1u == (tg + 1u) * nx) xb_add(&bar[XB_TOPGEN], 1u);
            else XB_SPIN(xb_ld(&bar[XB_TOPGEN]) == tg, bar);
            __builtin_amdgcn_fence(__ATOMIC_ACQUIRE, "agent");
            xb_add(&bar[XB_XGEN(b.x)], 1u);
            asm volatile("s_waitcnt vmcnt(0)" ::: "memory");
        } else {
            XB_SPIN(xb_ld(&bar[XB_XGEN(b.x)]) == gen, bar);
            __builtin_amdgcn_fence(__ATOMIC_ACQUIRE, "agent");
            asm volatile("s_waitcnt vmcnt(0)" ::: "memory");
        }
    }
    __syncthreads();
}

template <int OFF> __device__ __forceinline__ const void* karg_ptr() {
    unsigned long long v; auto k = __builtin_amdgcn_kernarg_segment_ptr();
    asm volatile("s_load_dwordx2 %0, %1, %2\n\ts_waitcnt lgkmcnt(0)" : "=s"(v) : "s"(k), "n"(OFF) : "memory");
    return (const void*)(const __attribute__((address_space(1))) void*)v; }
#define IN_PTR(i) ((const float*)karg_ptr<8 * (i)>())
#define OUT_PTR() ((float*)karg_ptr<128>())
#define WS_PTR() ((unsigned char*)karg_ptr<136>())

__device__ __forceinline__ int otid() { int t = threadIdx.x; asm volatile("" : "+v"(t)); return t; }
__device__ __forceinline__ int obx() { int t = blockIdx.x; asm volatile("" : "+s"(t)); return t; }
__device__ __forceinline__ int ogdim() { int t = gridDim.x; asm volatile("" : "+s"(t)); return t; }

#define LDS_BAR() do { asm volatile("s_waitcnt lgkmcnt(0)" ::: "memory"); __builtin_amdgcn_s_barrier(); asm volatile("" ::: "memory"); } while (0)
__device__ __forceinline__ void gla_pre_item(LAS unsigned char* lds, int item, const bf16* XB, const bf16* Wfz, const float* SSQ, const bf16* Kb, const float* wfg2, const float* bfg, bf16* KDT, float* GAM) {
    const int tid = otid(), lane = tid & 63, w = __builtin_amdgcn_readfirstlane(tid >> 6), l15 = lane & 15, lq = lane >> 4;
    const int b = item >> 6, c = item & 63;
    const size_t row0 = (size_t)b * SEQ + (size_t)c * 64;
    LAS float* fzs = (LAS float*)lds;
    LAS float* tot = (LAS float*)(lds + 4096);
    LAS f32x4* part = (LAS f32x4*)(lds + 8192);
    LAS float* rsd = (LAS float*)(lds + 12288);
    LAS unsigned char* img = lds + 16384;
    const int kcol = tid & 127, tg = tid >> 7;
    { const float* sp = SSQ + (row0 + (tid >> 3)) * 16 + (tid & 7) * 2; float v = sp[0] + sp[1];
      v += __shfl_xor(v, 1); v += __shfl_xor(v, 2); v += __shfl_xor(v, 4);
      if ((tid & 7) == 0) rsd[tid >> 3] = __builtin_amdgcn_rsqf(v * (1.0f / 1024.0f) + 1e-6f); }
    float wfn[16]; float bfn; unsigned short kn[16];
#define PRE_LOAD(hh) do { _Pragma("unroll") for (int r = 0; r < 16; ++r) wfn[r] = wfg2[r * 512 + (hh) * 128 + kcol]; bfn = bfg[(hh) * 128 + kcol]; \
        const bf16* kp_ = Kb + (row0 + tg * 16) * 512 + (hh) * 128 + kcol; _Pragma("unroll") for (int i = 0; i < 16; ++i) kn[i] = kp_[i * 512]; } while (0)
    PRE_LOAD(0);
    { const int mt = w & 3, kh = w >> 2; f32x4 acc = (f32x4){0.f, 0.f, 0.f, 0.f};
      const bf16* ap = XB + (row0 + 16 * mt + l15) * 1024 + 512 * kh + 8 * lq; const bf16* bp = Wfz + (size_t)l15 * 1024 + 512 * kh + 8 * lq;
#pragma unroll
      for (int ks = 0; ks < 16; ++ks) acc = __builtin_amdgcn_mfma_f32_16x16x32_bf16(*(const bf16x8*)(ap + 32 * ks), *(const bf16x8*)(bp + 32 * ks), acc, 0, 0, 0);
      if (kh == 1) part[mt * 64 + lane] = acc;
      LDS_BAR();
      if (kh == 0) { const f32x4 o = part[mt * 64 + lane] + acc;
#pragma unroll
          for (int r = 0; r < 4; ++r) { const int tok = 16 * mt + 4 * lq + r; fzs[tok * 16 + l15] = o[r] * rsd[tok]; } }
      LDS_BAR(); }
#pragma unroll 1
    for (int h = 0; h < 4; ++h) {
        const int it = ((b * 4 + h) << 6) + c;
        if (h > 0) { v4u* dstp = (v4u*)(KDT + (size_t)(it - 64) * 8192); const int p0 = tid, p1 = tid + 512;
            dstp[p0] = *(const LAS v4u*)(img + (p0 >> 3) * 144 + (p0 & 7) * 16); dstp[p1] = *(const LAS v4u*)(img + (p1 >> 3) * 144 + (p1 & 7) * 16); }
        float wf[16]; unsigned short kc[16];
#pragma unroll
        for (int r = 0; r < 16; ++r) { wf[r] = wfn[r]; kc[r] = kn[r]; }
        const float bf = bfn;
        { const int hn = (h < 3) ? h + 1 : 3; PRE_LOAD(hn); }
        float cum[16]; float run = 0.f;
#pragma unroll
        for (int i = 0; i < 16; ++i) { const LAS f32x4* z = (const LAS f32x4*)(fzs + (tg * 16 + i) * 16); float f = bf;
#pragma unroll
            for (int r4 = 0; r4 < 4; ++r4) { const f32x4 zz = z[r4]; f += zz.x * wf[4 * r4] + zz.y * wf[4 * r4 + 1] + zz.z * wf[4 * r4 + 2] + zz.w * wf[4 * r4 + 3]; }
            const float la = (fminf(f, 0.f) - __logf(1.0f + __expf(-fabsf(f)))) * (1.0f / 16.0f);
            run += la; cum[i] = run; }
        tot[tg * 128 + kcol] = run;
        LDS_BAR();
        float pre = 0.f, all = 0.f;
#pragma unroll
        for (int g = 0; g < 4; ++g) { const float tv = tot[g * 128 + kcol]; all += tv; if (g < tg) pre += tv; }
        unsigned pk[8];
#pragma unroll
        for (int i = 0; i < 8; ++i) { const float e0 = __expf(all - (pre + cum[2 * i])), e1 = __expf(all - (pre + cum[2 * i + 1]));
            pk[i] = pk2(__uint_as_float((unsigned)kc[2 * i] << 16) * e0, __uint_as_float((unsigned)kc[2 * i + 1] << 16) * e1); }
        { LAS v4u* dst = (LAS v4u*)(img + kcol * 144 + tg * 32); dst[0] = (v4u){pk[0], pk[1], pk[2], pk[3]}; dst[1] = (v4u){pk[4], pk[5], pk[6], pk[7]}; }
        if (tg == 0) GAM[(size_t)it * 128 + kcol] = __expf(all);
        LDS_BAR();
    }
    { v4u* dstp = (v4u*)(KDT + (size_t)(((b * 4 + 3) << 6) + c) * 8192); const int p0 = tid, p1 = tid + 512;
      dstp[p0] = *(const LAS v4u*)(img + (p0 >> 3) * 144 + (p0 & 7) * 16); dstp[p1] = *(const LAS v4u*)(img + (p1 >> 3) * 144 + (p1 & 7) * 16); }
    LDS_BAR();
#undef PRE_LOAD
}

__device__ __forceinline__ void gla_scan_item(LAS unsigned char* lds, int item, const bf16* Qb, const bf16* Vb, bf16* Ob, const bf16* KDT, const float* GAM, float* GSSQ) {
    const int tid = otid(), lane = tid & 63, w = __builtin_amdgcn_readfirstlane(tid >> 6);
    const int b = item >> 5, h = (item >> 3) & 3, vs = item & 7, bh = b * 4 + h;
    const size_t rb = (size_t)b * SEQ;
    LAS unsigned char* vt = lds;
    LAS unsigned char* st = lds + 4608;
    LAS unsigned char* kdt = lds + 13312;
    LAS unsigned char* qt = lds + 31744;
    f32x4 S0 = (f32x4){0.f, 0.f, 0.f, 0.f}, S1 = (f32x4){0.f, 0.f, 0.f, 0.f};
    const int mt = w >> 1, nt = w & 1, l15 = lane & 15, lq = lane >> 4;
    const int vtok = tid >> 3, vc4 = (tid & 7) * 4;
    const bf16* kdp = KDT + (size_t)bh * 64 * 8192 + (size_t)tid * 8;
    const bf16* qp = Qb + (rb + (tid >> 4)) * 512 + h * 128 + (tid & 15) * 8;
    const float* gp = GAM + (size_t)bh * 64 * 128 + 16 * w + 4 * lq;
    const bf16* vp = Vb + (rb + vtok) * 1024 + h * 256 + vs * 32 + vc4;
    const int kd_dst = (tid >> 3) * 144 + (tid & 7) * 16, q_dst = (tid >> 4) * 272 + (tid & 15) * 16;
    v4u KA[4][2], QA[4][2]; f32x4 G4[4]; v2u VN[4];
#define GLA_LOAD(j, c) do { KA[j][0] = *(const v4u*)(kdp + (size_t)(c) * 8192); KA[j][1] = *(const v4u*)(kdp + (size_t)(c) * 8192 + 4096); \
        QA[j][0] = *(const v4u*)(qp + (size_t)(c) * 64 * 512); QA[j][1] = *(const v4u*)(qp + (size_t)(c) * 64 * 512 + 32 * 512); \
        G4[j] = *(const f32x4*)(gp + (size_t)(c) * 128); VN[j] = *(const v2u*)(vp + (size_t)(c) * 64 * 1024); } while (0)
#pragma unroll
    for (int j = 0; j < 4; ++j) GLA_LOAD(j, j);
#pragma unroll 1
    for (int c0 = 0; c0 < 64; c0 += 4) {
#pragma unroll
        for (int j = 0; j < 4; ++j) {
            const int c = c0 + j; LAS unsigned char* qtc = qt + (j & 1) * 17408;
            { LAS unsigned short* vts = (LAS unsigned short*)vt; const v2u vc = VN[j];
              vts[(vc4 + 0) * 72 + vtok] = (unsigned short)(vc.x & 0xffffu); vts[(vc4 + 1) * 72 + vtok] = (unsigned short)(vc.x >> 16);
              vts[(vc4 + 2) * 72 + vtok] = (unsigned short)(vc.y & 0xffffu); vts[(vc4 + 3) * 72 + vtok] = (unsigned short)(vc.y >> 16);
              *(LAS v4u*)(kdt + kd_dst) = KA[j][0]; *(LAS v4u*)(kdt + kd_dst + 64 * 144) = KA[j][1];
              *(LAS v4u*)(qtc + q_dst) = QA[j][0]; *(LAS v4u*)(qtc + q_dst + 32 * 272) = QA[j][1]; }
            const f32x4 g4 = G4[j];
            { const int cn = (c + 4 < 64) ? c + 4 : 63; GLA_LOAD(j, cn); }
            LDS_BAR();
            { S0 = S0 * g4; S1 = S1 * g4;
#pragma unroll
              for (int ks = 0; ks < 2; ++ks) {
                  const bf16x8 a = *(const LAS bf16x8*)(kdt + (16 * w + l15) * 144 + (8 * lq + 32 * ks) * 2);
                  const bf16x8 b0 = *(const LAS bf16x8*)(vt + l15 * 144 + (8 * lq + 32 * ks) * 2);
                  const bf16x8 b1 = *(const LAS bf16x8*)(vt + (16 + l15) * 144 + (8 * lq + 32 * ks) * 2);
                  S0 = __builtin_amdgcn_mfma_f32_16x16x32_bf16(a, b0, S0, 0, 0, 0);
                  S1 = __builtin_amdgcn_mfma_f32_16x16x32_bf16(a, b1, S1, 0, 0, 0); }
              *(LAS v2u*)(st + l15 * 272 + (16 * w + 4 * lq) * 2) = (v2u){pk2(S0[0], S0[1]), pk2(S0[2], S0[3])};
              *(LAS v2u*)(st + (16 + l15) * 272 + (16 * w + 4 * lq) * 2) = (v2u){pk2(S1[0], S1[1]), pk2(S1[2], S1[3])}; }
            LDS_BAR();
            { f32x4 o = (f32x4){0.f, 0.f, 0.f, 0.f};
#pragma unroll
              for (int ks = 0; ks < 4; ++ks) { const bf16x8 sa = *(const LAS bf16x8*)(st + (16 * nt + l15) * 272 + (8 * lq + 32 * ks) * 2);
                  const bf16x8 qb = *(const LAS bf16x8*)(qtc + (16 * mt + l15) * 272 + (8 * lq + 32 * ks) * 2);
                  o = __builtin_amdgcn_mfma_f32_16x16x32_bf16(sa, qb, o, 0, 0, 0); }
              const size_t row = rb + (size_t)c * 64 + 16 * mt + l15;
              *(v2u*)(Ob + row * 1024 + h * 256 + vs * 32 + 16 * nt + 4 * lq) = (v2u){pk2(o[0], o[1]), pk2(o[2], o[3])};
              float ss = (o[0] * o[0] + o[1] * o[1]) + (o[2] * o[2] + o[3] * o[3]);
              ss += __shfl_xor(ss, 16); ss += __shfl_xor(ss, 32);
              GSSQ[(size_t)(h * 16 + vs * 2 + nt) * M + row] = ss; }
        }
    }
#undef GLA_LOAD
    __syncthreads();
}

__device__ __forceinline__ int fill_rstd(LAS unsigned char* lds, const float* ssq, const pg8::StaticOrder& S) {
    pg8::Unit u0; u0.pm = 0; u0.pn = 0; (void)S.next(0, u0);
    const int tid = otid(); LAS float* tab = (LAS float*)(lds + 131072 + 1024);
    float v[4][2];
#pragma unroll
    for (int s = 0; s < 4; ++s) { const int pm = (u0.pm + 8 * s < M / 256) ? u0.pm + 8 * s : M / 256 - 1;
        const f32x4* p = (const f32x4*)(ssq + (size_t)pm * 256 * 16) + tid;
        const f32x4 a = p[0], b = p[512]; v[s][0] = (a.x + a.y) + (a.z + a.w); v[s][1] = (b.x + b.y) + (b.z + b.w); }
#pragma unroll
    for (int s = 0; s < 4; ++s)
#pragma unroll
        for (int i = 0; i < 2; ++i) { float t = v[s][i]; t += __shfl_xor(t, 1); t += __shfl_xor(t, 2);
            if ((tid & 3) == 0) tab[s * 256 + (tid >> 2) + 128 * i] = __builtin_amdgcn_rsqf(t * (1.0f / 1024.0f) + 1e-6f); }
    __syncthreads();
    return u0.pm;
}
#define RTAB(pm0) pg8::RTab{(const LAS float*)(lds + 131072 + 1024), (pm0)}

#ifndef RPT_P1
#define RPT_P1 1
#endif
#ifndef RPT_P4
#define RPT_P4 1
#endif
#ifndef RPT_P6
#define RPT_P6 1
#endif
#ifndef RPT_P8
#define RPT_P8 1
#endif
#ifndef REPS
#define REPS 1
#endif
#define P4_FENCE() do { asm volatile("s_waitcnt vmcnt(0)" ::: "memory"); __builtin_amdgcn_fence(__ATOMIC_ACQUIRE, "agent"); asm volatile("s_waitcnt vmcnt(0)" ::: "memory"); __syncthreads(); } while (0)
#define WSP(T, off) ((T*)(WS_PTR() + (off)))
__global__ void __launch_bounds__(512, 2) fwd_mega(Args a) {
    extern __shared__ __attribute__((aligned(16))) unsigned char lds_raw[];
    cg::grid_group grid = cg::this_grid();
    LAS unsigned char* lds = (LAS unsigned char*)lds_raw;
#define TID (otid())
#define LANE (TID & 63)
#define WAVE (__builtin_amdgcn_readfirstlane(TID >> 6))
#define GDIM (ogdim())
#define BX (obx())
#define VCU ((GDIM % 8 == 0) ? (BX % 8) * (GDIM / 8) + BX / 8 : BX)
#define GW (VCU * 8 + WAVE)
#define NGW (GDIM * 8)

    for (int u = TID; u < (LDS_BYTES - 131072) / 4; u += 512) ((LAS unsigned*)(lds + 131072))[u] = 0u;
    __syncthreads();
    (void)xcd_barrier_post((unsigned*)(WS_PTR() + 16384), (volatile LAS unsigned*)(lds + 131072 + 352));
#define GRID_SYNC() do { XcdBarrier b_; b_.bar = (unsigned*)(WS_PTR() + 16384); b_.x = xb_xcc_id(); b_.st = (volatile LAS unsigned*)(lds + 131072 + 352); xcd_barrier(b_); } while (0)
#pragma unroll 1
    for (int rep = 0; rep < REPS; ++rep) {
#ifndef SKIP_P0
    {
        const int lane = LANE, gw = GW, ngw = NGW;
        unsigned char* ws = WS_PTR();
        LAS float* scr = (LAS float*)(lds + WAVE * 16384);
        constexpr int I_IN = 16 * 264, I_SQ = 512, I_GU = 16 * 176, I_D = 44 * 32, I_L = I_IN + 3 * I_SQ + I_GU + I_D;
        for (int it = gw; it < 2 * I_L; it += ngw) {
            const int l = it / I_L; int r = it % I_L; unsigned char* wb = ws + WS_W0 + (size_t)l * WS_WL;
            if (r < I_IN) { const int kb = r / 264, nb = r % 264; tr_item(IN_PTR(2) + (size_t)l * D * NIN, NIN, in_src_col(nb * 32 + (lane & 31)), IN_PTR(1) + l * D, (bf16*)(wb + WO_IN), D, nb * 32, kb * 64, scr, lane); continue; }
            r -= I_IN;
            if (r < 3 * I_SQ) { const int which = r / I_SQ, r2 = r % I_SQ, kb = r2 / 32, nb = r2 % 32; const float* src = (which == 0 ? IN_PTR(6) : which == 1 ? IN_PTR(9) : IN_PTR(10)) + (size_t)l * D * D;
                tr_item(src, D, nb * 32 + (lane & 31), nullptr, (bf16*)(wb + WO_OA + (size_t)which * 2 * MiB), D, nb * 32, kb * 64, scr, lane); continue; }
            r -= 3 * I_SQ;
            if (r < I_GU) { const int kb = r / 176, nb = r % 176, d0 = nb * 32, j = d0 >> 8, i = d0 & 255; const float* src = (i >= 128 ? IN_PTR(13) : IN_PTR(12)) + (size_t)l * D * FF;
                tr_item(src, FF, 128 * j + (i & 127) + (lane & 31), IN_PTR(11) + l * D, (bf16*)(wb + WO_GU), D, d0, kb * 64, scr, lane); continue; }
            r -= I_GU;
            { const int kb = r / 32, nb = r % 32; tr_item(IN_PTR(14) + (size_t)l * FF * D, D, nb * 32 + (lane & 31), nullptr, (bf16*)(wb + WO_D), FF, nb * 32, kb * 64, scr, lane); }
        }
        const float* x = IN_PTR(0); bf16* XB = (bf16*)(ws + WS_XB); float* SSQ = (float*)(ws + WS_SSQ);
        for (int m = 4 * gw; m < M; m += 4 * ngw) {
            f32x4 v[4][4]; float s[4];
#pragma unroll
            for (int r = 0; r < 4; ++r)
#pragma unroll
                for (int j = 0; j < 4; ++j) v[r][j] = ((const f32x4*)(x + (size_t)(m + r) * D) + lane)[64 * j];
#pragma unroll
            for (int r = 0; r < 4; ++r) { float t = 0.f;
#pragma unroll
                for (int j = 0; j < 4; ++j) t += (v[r][j].x * v[r][j].x + v[r][j].y * v[r][j].y) + (v[r][j].z * v[r][j].z + v[r][j].w * v[r][j].w);
                s[r] = wave_sum(t); }
#pragma unroll
            for (int r = 0; r < 4; ++r) { unsigned long long* o8 = (unsigned long long*)(XB + (size_t)(m + r) * D) + lane;
#pragma unroll
                for (int j = 0; j < 4; ++j) o8[64 * j] = (unsigned long long)pk2(v[r][j].x, v[r][j].y) | ((unsigned long long)pk2(v[r][j].z, v[r][j].w) << 32); }
            SSQ[(size_t)m * 16 + lane] = (lane == 0) ? s[0] : (lane == 16) ? s[1] : (lane == 32) ? s[2] : (lane == 48) ? s[3] : 0.f;
        }
    }
#endif
    asm volatile("s_waitcnt vmcnt(0)" ::: "memory"); grid.sync();
    if (WAVE == 0) { __builtin_amdgcn_fence(__ATOMIC_ACQUIRE, "agent"); asm volatile("s_waitcnt vmcnt(0)" ::: "memory"); }
    __syncthreads();

#pragma unroll 1
    for (int l = 0; l < 2; ++l) {
#ifndef SKIP_P1
        for (int rp = 0; rp < RPT_P1; ++rp) { unsigned char* ws = WS_PTR();
          pg8::Gemm g{(const bf16*)(ws + WS_XB), (const bf16*)(ws + WS_W0 + (size_t)l * WS_WL + WO_IN), M, 5120, D}; pg8::P1Order S; S.init(M, 5120, GDIM, BX); const int pm0 = fill_rstd(lds, (const float*)(ws + WS_SSQ), S);
          pg8::EpiInProj E{(bf16*)(ws + WS_Q), (bf16*)(ws + WS_K), (bf16*)(ws + WS_V), (bf16*)(ws + WS_R), (bf16*)(ws + WS_U), (bf16*)(ws + WS_GBIN), (float*)(ws + WS_FZ), RTAB(pm0)};
          pg8::gemm_phase<pg8::EpiInProj, pg8::P1Order, true, true>(lds, g, S, E); }
#endif
        GRID_SYNC();
#ifndef SKIP_GLA
        { unsigned char* ws = WS_PTR();
          for (int item = VCU; item < 512; item += GDIM)
              gla_pre_item(lds, item, (const bf16*)(ws + WS_XB), (const bf16*)(ws + WS_W0 + (size_t)l * WS_WL + WO_IN) + (size_t)6144 * D, (const float*)(ws + WS_SSQ), (const bf16*)(ws + WS_K),
                           IN_PTR(3) + (size_t)l * 16 * 512, IN_PTR(4) + l * 512, (bf16*)(ws + WS_KDT), (float*)(ws + WS_GAM)); }
#endif
#ifndef SKIP_CONV
        {
            const int lane = LANE, gw = GW, ngw = NGW;
            unsigned char* ws = WS_PTR(); const bf16* Ub = (const bf16*)(ws + WS_U); bf16* GBIN = (bf16*)(ws + WS_GBIN);
            const float* cw = IN_PTR(7) + (size_t)l * 3 * D; const float* cb = IN_PTR(8) + l * D;
            for (int run = gw; run < M / 8; run += ngw) {
                const int m0 = (run >> 1) * 16, c0 = (run & 1) * 512 + lane * 8;
                float w0[8], w1[8], w2[8], bb[8], um2[8], um1[8];
#pragma unroll
                for (int j = 0; j < 8; ++j) { w0[j] = cw[c0 + j]; w1[j] = cw[D + c0 + j]; w2[j] = cw[2 * D + c0 + j]; bb[j] = cb[c0 + j]; }
                if ((m0 & (SEQ - 1)) == 0) {
#pragma unroll
                    for (int j = 0; j < 8; ++j) { um2[j] = 0.f; um1[j] = 0.f; }
                } else { load8(Ub + (size_t)(m0 - 2) * D + c0, um2); load8(Ub + (size_t)(m0 - 1) * D + c0, um1); }
#pragma unroll 1
                for (int i0 = 0; i0 < 16; i0 += 4) {
                    v4u ur[4], gr[4];
#pragma unroll
                    for (int r = 0; r < 4; ++r) { const size_t off = (size_t)(m0 + i0 + r) * D + c0; ur[r] = *(const v4u*)(Ub + off); gr[r] = *(const v4u*)(GBIN + off); }
#pragma unroll
                    for (int r = 0; r < 4; ++r) { const size_t off = (size_t)(m0 + i0 + r) * D + c0; float u0[8], gg[8], o[8];
                        u0[0] = bflo(ur[r].x); u0[1] = bfhi(ur[r].x); u0[2] = bflo(ur[r].y); u0[3] = bfhi(ur[r].y); u0[4] = bflo(ur[r].z); u0[5] = bfhi(ur[r].z); u0[6] = bflo(ur[r].w); u0[7] = bfhi(ur[r].w);
                        gg[0] = bflo(gr[r].x); gg[1] = bfhi(gr[r].x); gg[2] = bflo(gr[r].y); gg[3] = bfhi(gr[r].y); gg[4] = bflo(gr[r].z); gg[5] = bfhi(gr[r].z); gg[6] = bflo(gr[r].w); gg[7] = bfhi(gr[r].w);
#pragma unroll
                        for (int j = 0; j < 8; ++j) { o[j] = gg[j] * (w0[j] * um2[j] + w1[j] * um1[j] + w2[j] * u0[j] + bb[j]); um2[j] = um1[j]; um1[j] = u0[j]; }
                        store8(GBIN + off, o); }
                }
            }
        }
#endif
        GRID_SYNC();
#ifdef PROBE_SCAN
        { unsigned char* ws = WS_PTR();
          for (int item = VCU; item < 256; item += GDIM)
              gla_scan_item(lds, item, (const bf16*)(ws + WS_Q), (const bf16*)(ws + WS_V), (bf16*)(ws + WS_R), (const bf16*)(ws + WS_KDT), (const float*)(ws + WS_GAM), (float*)(ws + WS_GSSQ)); }
#endif
#ifndef SKIP_GLA
        { unsigned char* ws = WS_PTR();
          for (int item = VCU; item < 256; item += GDIM)
              gla_scan_item(lds, item, (const bf16*)(ws + WS_Q), (const bf16*)(ws + WS_V), (bf16*)(ws + WS_V), (const bf16*)(ws + WS_KDT), (const float*)(ws + WS_GAM), (float*)(ws + WS_GSSQ)); }
#endif
        GRID_SYNC();
#ifndef SKIP_P4
        { unsigned char* ws = WS_PTR(); const bf16* Win = (const bf16*)(ws + WS_W0 + (size_t)l * WS_WL + WO_IN); const bf16* XBp = (const bf16*)(ws + WS_XB);
          pg8::Gemm4 g{XBp, XBp, XBp, XBp, Win + (size_t)2048 * D, Win + (size_t)NIN1 * D, Win + (size_t)(NIN1 + D) * D, Win + (size_t)(NIN1 + D) * D, M, D, D};
          pg8::ChainOrder S; S.init(M, D, GDIM, BX); S.tpw = (M / 256) * (D / 256) / GDIM; S.ns = 3; const int pm0 = fill_rstd(lds, (const float*)(ws + WS_SSQ), S);
          if (S.tpw * GDIM == (M / 256) * (D / 256)) {
          pg8::EpiX E{pg8::EpiO{(bf16*)(ws + WS_V), (const float*)(ws + WS_GSSQ), IN_PTR(5) + l * 256, RTAB(pm0)}, pg8::EpiGate{(bf16*)(ws + WS_GA), RTAB(pm0)}, pg8::EpiGate{(bf16*)(ws + WS_GB), RTAB(pm0)}};
          pg8::gemm_phase<pg8::EpiX, pg8::ChainOrder, true, true, pg8::Gemm4>(lds, g, S, E); } }
#endif
        GRID_SYNC();
#ifndef SKIP_P4
        { unsigned char* ws = WS_PTR();
          const bf16* Ao = (const bf16*)(ws + WS_V); const bf16* Ac = (const bf16*)(ws + WS_GBIN); const bf16* Ba = (const bf16*)(ws + WS_W0 + (size_t)l * WS_WL + WO_OA); const bf16* Bb = (const bf16*)(ws + WS_W0 + (size_t)l * WS_WL + WO_OB);
          pg8::Gemm4 g{Ao, Ac, Ac, Ac, Ba, Bb, Bb, Bb, M, D, D};
          pg8::ChainOrder S; S.init(M, D, GDIM, BX); S.tpw = (M / 256) * (D / 256) / GDIM; S.ns = 2;
          if (S.tpw * GDIM == (M / 256) * (D / 256)) {
          pg8::EpiY E{pg8::EpiMix<0>{(const bf16*)(ws + WS_GA), (bf16*)(ws + WS_GA)}, pg8::EpiMix<1>{(const bf16*)(ws + WS_GB), (bf16*)(ws + WS_GA)}};
          pg8::gemm_phase<pg8::EpiY, pg8::ChainOrder, true, true, pg8::Gemm4>(lds, g, S, E); } }
#endif
        GRID_SYNC();
#ifndef SKIP_P5
        { unsigned char* ws = WS_PTR();
          pg8::Gemm g{(const bf16*)(ws + WS_GA), (const bf16*)(ws + WS_W0 + (size_t)l * WS_WL + WO_O), M, D, D}; pg8::StaticOrder S; S.init(M, D, GDIM, BX);
          pg8::EpiRes E{(bf16*)(ws + WS_XB), (float*)(ws + WS_SSQ)};
          pg8::gemm_phase<pg8::EpiRes, pg8::StaticOrder, true, true>(lds, g, S, E); }
#endif
        GRID_SYNC();
#ifndef SKIP_P6
        for (int rp = 0; rp < RPT_P6; ++rp) { unsigned char* ws = WS_PTR();
          pg8::Gemm g{(const bf16*)(ws + WS_XB), (const bf16*)(ws + WS_W0 + (size_t)l * WS_WL + WO_GU), M, NGU, D}; pg8::StaticOrder S; S.init(M, NGU, GDIM, BX); const int pm0 = fill_rstd(lds, (const float*)(ws + WS_SSQ), S);
          pg8::EpiFfn1 E{(bf16*)(ws + WS_HID), RTAB(pm0)};
          pg8::gemm_phase<pg8::EpiFfn1, pg8::StaticOrder, true, true>(lds, g, S, E); }
#endif
        GRID_SYNC();
#ifndef SKIP_P7
        { unsigned char* ws = WS_PTR();
          pg8::Gemm g{(const bf16*)(ws + WS_HID), (const bf16*)(ws + WS_W0 + (size_t)l * WS_WL + WO_D), M, D, FF}; pg8::StaticOrder S; S.init(M, D, GDIM, BX);
          pg8::EpiRes E{(bf16*)(ws + WS_XB), (float*)(ws + WS_SSQ)};
          pg8::gemm_phase<pg8::EpiRes, pg8::StaticOrder, true, true>(lds, g, S, E); }
#endif
        GRID_SYNC();
    }
    for (int rp8 = 0; rp8 < RPT_P8; ++rp8) {
        const int lane = LANE, gw = GW, ngw = NGW;
        float* out = OUT_PTR(); const float* SSQ = (const float*)(WS_PTR() + WS_SSQ); const bf16* XB = (const bf16*)(WS_PTR() + WS_XB);
        f32x4 g4[4];
#pragma unroll
        for (int j = 0; j < 4; ++j) g4[j] = ((const f32x4*)IN_PTR(15))[64 * j + lane];
        for (int m = 4 * gw; m < M; m += 4 * ngw) {
            float s[4]; v2u xv[4][4];
#pragma unroll
            for (int r = 0; r < 4; ++r) { s[r] = SSQ[(size_t)(m + r) * 16 + (lane & 15)];
#pragma unroll
                for (int j = 0; j < 4; ++j) xv[r][j] = ((const v2u*)(XB + (size_t)(m + r) * D))[64 * j + lane]; }
#pragma unroll
            for (int r = 0; r < 4; ++r) { float t = (lane < 16) ? s[r] : 0.f; t = wave_sum(t);
                const float rstd = __builtin_amdgcn_rsqf(t * (1.0f / 1024.0f) + 1e-6f);
                f32x4* o = (f32x4*)(out + (size_t)(m + r) * D);
#pragma unroll
                for (int j = 0; j < 4; ++j) o[64 * j + lane] = (f32x4){bflo(xv[r][j].x), bfhi(xv[r][j].x), bflo(xv[r][j].y), bfhi(xv[r][j].y)} * rstd * g4[j]; }
        }
    }
    GRID_SYNC();
    }
}

extern "C" void kernel_launch(void* const* d_in, const int* in_sizes, int n_in, void* d_out, int out_size, void* d_ws, size_t ws_size, hipStream_t stream) {
    static int grid = 0;
    if (grid == 0) {
        if (n_in != 16 || in_sizes[0] != M * D || out_size != M * D || ws_size < WS_END) { fprintf(stderr, "kernel_launch: unexpected shapes / workspace (n_in %d, ws %zu)\n", n_in, ws_size); grid = -1; return; }
        int dev = 0, cus = 0, per_cu = 0;
        if (hipGetDevice(&dev) != hipSuccess || hipDeviceGetAttribute(&cus, hipDeviceAttributeMultiprocessorCount, dev) != hipSuccess) { grid = -1; return; }
        if (hipFuncSetAttribute((const void*)fwd_mega, hipFuncAttributeMaxDynamicSharedMemorySize, LDS_BYTES) != hipSuccess) { fprintf(stderr, "kernel_launch: hipFuncSetAttribute failed\n"); grid = -1; return; }
        if (hipOccupancyMaxActiveBlocksPerMultiprocessor(&per_cu, (const void*)fwd_mega, 512, LDS_BYTES) != hipSuccess || per_cu < 1) { fprintf(stderr, "kernel_launch: occupancy query says %d blocks per CU\n", per_cu); per_cu = 1; }
        (void)hipGetLastError();
        grid = cus;
    }
    if (grid < 0) return;
    if (hipMemsetAsync(d_ws, 0, 1 << 20, stream) != hipSuccess) { fprintf(stderr, "kernel_launch: memset of the control words failed\n"); return; }
    Args a{};
    for (int i = 0; i < 16; ++i) a.in[i] = (const float*)d_in[i];
    a.out = (float*)d_out; a.ws = (unsigned char*)d_ws;
    void* args[] = {&a};
    hipError_t e = hipLaunchCooperativeKernel((const void*)fwd_mega, dim3(grid), dim3(512), args, LDS_BYTES, stream);
    if (e != hipSuccess) fprintf(stderr, "kernel_launch: cooperative launch failed: %s (grid %d)\n", hipGetErrorString(e), grid);
}
```
